# Optimizing an MI355X kernel written in HIP

```python
import math
import jax, jax.numpy as jnp
from jax import lax
import numpy as np

D_MODEL = 1024
BATCH = 8
SEQ = 2048
DEPTH = 2

HEAD_DIM = 64
BLOCK = 128
WINDOW = 128
GRID_W = 64
A_HEADS = 6
A_KV_HEADS = 2
B_HEADS = 6
B_KV_HEADS = 2
C_HEADS = 6
C_V_DIM = 2 * HEAD_DIM
X_HEADS = 4
MEM_LEN = 256
REL_HEADS = 6
REL_BUCKETS = 32
REL_MAX_DIST = 128
ROPE_THETA = 10000.0
EPS = 1e-6
NEG_INF = -1e30
N_EVEN = (DEPTH + 1) // 2
N_ODD = DEPTH // 2

EVEN_MIX = (A_HEADS + B_HEADS + X_HEADS) * HEAD_DIM
ODD_MIX = C_HEADS * C_V_DIM + X_HEADS * HEAD_DIM
EVEN_SPLITS = (A_HEADS * HEAD_DIM, A_KV_HEADS * HEAD_DIM, A_KV_HEADS * HEAD_DIM,
               B_HEADS * HEAD_DIM, B_KV_HEADS * HEAD_DIM, B_KV_HEADS * HEAD_DIM,
               X_HEADS * HEAD_DIM, EVEN_MIX)
ODD_SPLITS = (C_HEADS * HEAD_DIM, C_HEADS * HEAD_DIM, C_HEADS * HEAD_DIM, C_HEADS * HEAD_DIM,
              C_HEADS * C_V_DIM, X_HEADS * HEAD_DIM, ODD_MIX)
EVEN_IN = sum(EVEN_SPLITS)
ODD_IN = sum(ODD_SPLITS)

kernel_name = "hybrid_window_axial_diff_encoder"


def _split(t, sizes):
    idx = [int(s) for s in np.cumsum(sizes)[:-1]]
    return jnp.split(t, idx, axis=-1)


def rmsnorm(x, g):
    xf = x.astype(jnp.float32)
    y = xf * lax.rsqrt(jnp.mean(xf * xf, axis=-1, keepdims=True) + EPS)
    return (y * g.astype(jnp.float32)).astype(x.dtype)


def t5_bucket(rel):
    nb = REL_BUCKETS // 2
    max_exact = nb // 2
    ret = jnp.where(rel > 0, nb, 0)
    n = jnp.abs(rel)
    nf = jnp.maximum(n, 1).astype(jnp.float32)
    large = max_exact + (jnp.log(nf / max_exact) / math.log(REL_MAX_DIST / max_exact)
                         * (nb - max_exact)).astype(jnp.int32)
    large = jnp.minimum(large, nb - 1)
    return ret + jnp.where(n < max_exact, n, large)


def rel_bias_lookup(table, rel):
    return jnp.moveaxis(table[t5_bucket(rel)], -1, 0).astype(jnp.float32)


def windowed_gqa_sink(q, k, v, sink, table):
    Bn, S, H, D = q.shape
    KVH = k.shape[2]
    G = H // KVH
    nb = S // BLOCK
    pad = ((0, 0), (WINDOW, WINDOW), (0, 0), (0, 0))
    kp = jnp.pad(k, pad).reshape(Bn, nb + 2, BLOCK, KVH, D)
    vp = jnp.pad(v, pad).reshape(Bn, nb + 2, BLOCK, KVH, D)
    kw = jnp.concatenate([kp[:, :-2], kp[:, 1:-1], kp[:, 2:]], axis=2)
    vw = jnp.concatenate([vp[:, :-2], vp[:, 1:-1], vp[:, 2:]], axis=2)
    qb = q.reshape(Bn, nb, BLOCK, KVH, G, D)
    logits = jnp.einsum("bnqkgd,bnskd->bnkgqs", qb, kw).astype(jnp.float32) * (D ** -0.5)
    a = jnp.arange(BLOCK)[:, None]
    c = jnp.arange(3 * BLOCK)[None, :]
    rel = c - BLOCK - a
    bias = rel_bias_lookup(table, rel).reshape(KVH, G, BLOCK, 3 * BLOCK)
    kpos = jnp.arange(nb)[:, None] * BLOCK - BLOCK + c
    valid = ((jnp.abs(rel) <= WINDOW)[None]
             & (kpos >= 0)[:, None, :] & (kpos < S)[:, None, :])
    logits = jnp.where(valid[None, :, None, None], logits + bias, NEG_INF)
    sink_col = jnp.broadcast_to(sink.astype(jnp.float32).reshape(1, 1, KVH, G, 1, 1),
                                logits.shape[:-1] + (1,))
    p = jax.nn.softmax(jnp.concatenate([logits, sink_col], axis=-1), axis=-1)[..., :-1]
    out = jnp.einsum("bnkgqs,bnskd->bnqkgd", p.astype(v.dtype), vw)
    return out.reshape(Bn, S, H, D)


def axial_rope_tables(S):
    rows = S // GRID_W
    row = jnp.broadcast_to(jnp.arange(rows)[:, None], (rows, GRID_W)).reshape(-1)
    col = jnp.broadcast_to(jnp.arange(GRID_W)[None, :], (rows, GRID_W)).reshape(-1)
    half = HEAD_DIM // 2
    inv = 1.0 / (ROPE_THETA ** (jnp.arange(0, half, 2, dtype=jnp.float32) / half))
    ang = jnp.concatenate([row.astype(jnp.float32)[:, None] * inv,
                           col.astype(jnp.float32)[:, None] * inv], axis=-1)
    return jnp.cos(ang), jnp.sin(ang)


def apply_axial_rope(x, cos, sin):
    Bn, S, H, D = x.shape
    quarter = D // 4
    xr = x.astype(jnp.float32).reshape(Bn, S, H, 2, 2, quarter)
    x1, x2 = xr[..., 0, :], xr[..., 1, :]
    c = cos.reshape(S, 2, quarter)[None, :, None]
    s = sin.reshape(S, 2, quarter)[None, :, None]
    out = jnp.stack([x1 * c - x2 * s, x1 * s + x2 * c], axis=-2)
    return out.reshape(Bn, S, H, D).astype(x.dtype)


def dense_gqa_blocked(q, k, v):
    Bn, S, H, D = q.shape
    KVH = k.shape[2]
    G = H // KVH
    nb = S // BLOCK
    qb = q.reshape(Bn, nb, BLOCK, KVH, G, D).transpose(1, 0, 2, 3, 4, 5)

    def blk(qi):
        s = jnp.einsum("bqkgd,bskd->bkgqs", qi, k).astype(jnp.float32) * (D ** -0.5)
        p = jax.nn.softmax(s, axis=-1)
        return jnp.einsum("bkgqs,bskd->bqkgd", p.astype(v.dtype), v)

    out = lax.map(blk, qb)
    return out.transpose(1, 0, 2, 3, 4, 5).reshape(Bn, S, H, D)


def diff_attention_blocked(q1, q2, k1, k2, v, lam, table):
    Bn, S, H, D = q1.shape
    nb = S // BLOCK
    qb = jnp.stack([q1, q2], 0).reshape(2, Bn, nb, BLOCK, H, D).transpose(2, 0, 1, 3, 4, 5)
    kk = jnp.stack([k1, k2], 0)
    kpos = jnp.arange(S)

    def blk(args):
        n, qi = args
        s = jnp.einsum("ibqhd,ibshd->ibhqs", qi, kk).astype(jnp.float32) * (D ** -0.5)
        rel = kpos[None, :] - (n * BLOCK + jnp.arange(BLOCK))[:, None]
        p = jax.nn.softmax(s + rel_bias_lookup(table, rel)[None, None], axis=-1)
        w = p[0] - lam * p[1]
        return jnp.einsum("bhqs,bshe->bqhe", w.astype(v.dtype), v)

    out = lax.map(blk, (jnp.arange(nb), qb))
    return out.transpose(1, 0, 2, 3, 4).reshape(Bn, S, H, v.shape[-1])


def memory_cross_attention(q, mem_n, w_mem_kv):
    Bn, M, _ = mem_n.shape
    mk, mv = jnp.split(mem_n @ w_mem_kv, 2, axis=-1)
    mk = mk.reshape(Bn, M, X_HEADS, HEAD_DIM)
    mv = mv.reshape(Bn, M, X_HEADS, HEAD_DIM)
    s = jnp.einsum("bshd,bmhd->bhsm", q, mk).astype(jnp.float32) * (HEAD_DIM ** -0.5)
    p = jax.nn.softmax(s, axis=-1)
    return jnp.einsum("bhsm,bmhd->bshd", p.astype(mv.dtype), mv)


def even_layer(x, mem_n, table, norm_g, w_in, sink, q_norm, k_norm, w_mem_kv, w_out):
    Bn, S, _ = x.shape
    h = rmsnorm(x, norm_g)
    aq, ak, av, bq, bk, bv, xq, gate = _split(h @ w_in, EVEN_SPLITS)
    heads = lambda t, n: t.reshape(Bn, S, n, HEAD_DIM)
    y_a = windowed_gqa_sink(heads(aq, A_HEADS), heads(ak, A_KV_HEADS), heads(av, A_KV_HEADS),
                            sink, table)
    cos, sin = axial_rope_tables(S)
    qb = apply_axial_rope(rmsnorm(heads(bq, B_HEADS), q_norm), cos, sin)
    kb = apply_axial_rope(rmsnorm(heads(bk, B_KV_HEADS), k_norm), cos, sin)
    y_b = dense_gqa_blocked(qb, kb, heads(bv, B_KV_HEADS))
    y_x = memory_cross_attention(heads(xq, X_HEADS), mem_n, w_mem_kv)
    y = jnp.concatenate([y_a.reshape(Bn, S, -1), y_b.reshape(Bn, S, -1),
                         y_x.reshape(Bn, S, -1)], axis=-1) * jax.nn.silu(gate)
    return x + y @ w_out


def odd_layer(x, mem_n, table, norm_g, w_in, lq1, lk1, lq2, lk2, subln_g, w_mem_kv, w_out,
              lam_init):
    Bn, S, _ = x.shape
    h = rmsnorm(x, norm_g)
    q1, q2, k1, k2, v, xq, gate = _split(h @ w_in, ODD_SPLITS)
    heads = lambda t, n, d: t.reshape(Bn, S, n, d)
    lam = (jnp.exp(jnp.sum(lq1.astype(jnp.float32) * lk1.astype(jnp.float32)))
           - jnp.exp(jnp.sum(lq2.astype(jnp.float32) * lk2.astype(jnp.float32))) + lam_init)
    y_c = diff_attention_blocked(heads(q1, C_HEADS, HEAD_DIM), heads(q2, C_HEADS, HEAD_DIM),
                                 heads(k1, C_HEADS, HEAD_DIM), heads(k2, C_HEADS, HEAD_DIM),
                                 heads(v, C_HEADS, C_V_DIM), lam, table)
    y_c = rmsnorm(y_c, subln_g) * (1.0 - lam_init)
    y_x = memory_cross_attention(heads(xq, X_HEADS, HEAD_DIM), mem_n, w_mem_kv)
    y = jnp.concatenate([y_c.reshape(Bn, S, -1), y_x.reshape(Bn, S, -1)], axis=-1) \
        * jax.nn.silu(gate)
    return x + y @ w_out


def setup_inputs(seed: int = 0) -> dict:
    key = jax.random.key(seed)
    ks = jax.random.split(key, 21)
    f32 = jnp.float32
    nrm = lambda k, shape, s: jax.random.normal(k, shape, f32) * s
    gain = lambda k, shape: 1.0 + 0.02 * jax.random.normal(k, shape, f32)
    dinv = D_MODEL ** -0.5
    return {
        "x": nrm(ks[0], (BATCH, SEQ, D_MODEL), 1.0),
        "mem": nrm(ks[1], (BATCH, MEM_LEN, D_MODEL), 1.0),
        "rel_bias": nrm(ks[2], (REL_BUCKETS, REL_HEADS), 0.5),
        "mem_norm": gain(ks[3], (D_MODEL,)),
        "final_norm": gain(ks[4], (D_MODEL,)),
        "even_norm": gain(ks[5], (N_EVEN, D_MODEL)),
        "even_w_in": nrm(ks[6], (N_EVEN, D_MODEL, EVEN_IN), dinv),
        "even_sink": nrm(ks[7], (N_EVEN, A_HEADS), 1.0),
        "even_q_norm": gain(ks[8], (N_EVEN, HEAD_DIM)),
        "even_k_norm": gain(ks[9], (N_EVEN, HEAD_DIM)),
        "even_w_mem_kv": nrm(ks[10], (N_EVEN, D_MODEL, 2 * X_HEADS * HEAD_DIM), dinv),
        "even_w_out": nrm(ks[11], (N_EVEN, EVEN_MIX, D_MODEL), EVEN_MIX ** -0.5),
        "odd_norm": gain(ks[12], (N_ODD, D_MODEL)),
        "odd_w_in": nrm(ks[13], (N_ODD, D_MODEL, ODD_IN), dinv),
        "odd_lambda_q1": nrm(ks[14], (N_ODD, HEAD_DIM), 0.1),
        "odd_lambda_k1": nrm(ks[15], (N_ODD, HEAD_DIM), 0.1),
        "odd_lambda_q2": nrm(ks[16], (N_ODD, HEAD_DIM), 0.1),
        "odd_lambda_k2": nrm(ks[17], (N_ODD, HEAD_DIM), 0.1),
        "odd_subln": gain(ks[18], (N_ODD, C_V_DIM)),
        "odd_w_mem_kv": nrm(ks[19], (N_ODD, D_MODEL, 2 * X_HEADS * HEAD_DIM), dinv),
        "odd_w_out": nrm(ks[20], (N_ODD, ODD_MIX, D_MODEL), ODD_MIX ** -0.5),
    }


def reference(x, mem, rel_bias, mem_norm, final_norm, even_norm, even_w_in, even_sink,
              even_q_norm, even_k_norm, even_w_mem_kv, even_w_out, odd_norm, odd_w_in,
              odd_lambda_q1, odd_lambda_k1, odd_lambda_q2, odd_lambda_k2, odd_subln,
              odd_w_mem_kv, odd_w_out):
    mem_n = rmsnorm(mem, mem_norm)
    h = x
    for i in range(DEPTH):
        j = i // 2
        if i % 2 == 0:
            h = even_layer(h, mem_n, rel_bias, even_norm[j], even_w_in[j], even_sink[j],
                           even_q_norm[j], even_k_norm[j], even_w_mem_kv[j], even_w_out[j])
        else:
            lam_init = 0.8 - 0.6 * math.exp(-0.3 * i)
            h = odd_layer(h, mem_n, rel_bias, odd_norm[j], odd_w_in[j], odd_lambda_q1[j],
                          odd_lambda_k1[j], odd_lambda_q2[j], odd_lambda_k2[j], odd_subln[j],
                          odd_w_mem_kv[j], odd_w_out[j], lam_init)
    return rmsnorm(h, final_norm)
```

```cpp
#include <hip/hip_runtime.h>
#include <cstdio>
#include <cstdint>
namespace pg8 {
#define PG8_LAS __attribute__((address_space(3)))
typedef unsigned short bf16_t;
typedef short bf16x8 __attribute__((ext_vector_type(8)));
typedef float f32x4 __attribute__((ext_vector_type(4)));
typedef unsigned u32x4 __attribute__((ext_vector_type(4)));
constexpr int BM = 256, BK = 64, HALF = 128, HTB = HALF * BK * 2  , STAGE_BYTES = 8 * HTB, NXCD = 8, WGM = 8;

__host__ __device__ __forceinline__ int lds_byte(int r, int c) { const int st = (r >> 4) * 2 + (c >> 5), rr = r & 15, cc = c & 31, ob = rr * 64 + cc * 2; return st * 1024 + (ob ^ (((ob >> 9) & 1) << 5)); }
__host__ __device__ __forceinline__ void stage_rc(int b, int& R, int& C) { const int st = b / 1024, sb = b % 1024, swz = sb ^ (((sb >> 9) & 1) << 5); R = (st >> 1) * 16 + swz / 64; C = (st & 1) * 32 + (swz % 64) / 2; }
__host__ __device__ __forceinline__ int perm32(int rho) { const int n = rho >> 4, i = rho & 15; return 8 * (i >> 2) + 4 * n + (i & 3); }

struct Unit { int pm, pn; };
struct Gemm { const bf16_t* A; const bf16_t* Bt; int M, N, K; };

struct StaticOrder {
    int nM, nN, nwg, G, c;
    __host__ __device__ void init(int M, int N, int G_, int c_) { nM = M / BM; nN = N / BM; nwg = nM * nN; G = G_; c = c_; }
    __host__ __device__ bool next(int i, Unit& u) const {
        const long L = (long)i * G + c; if (L >= nwg) return false;
        int wgid = (int)L; { const int q = nwg / NXCD, r = nwg % NXCD, xcd = wgid % NXCD, off = wgid / NXCD; wgid = (xcd < r ? xcd * (q + 1) : r * (q + 1) + (xcd - r) * q) + off; }
        const int nig = WGM * nN, gid = wgid / nig, fm = gid * WGM, gsz = (nM - fm) < WGM ? (nM - fm) : WGM;
        u.pm = fm + ((wgid % nig) % gsz); u.pn = (wgid % nig) / gsz; return true;
    }
    __device__ __forceinline__ void a_ready(const Unit&) const {}
    __device__ __forceinline__ void done(const Unit&) const {}
};


typedef float f32x2_t __attribute__((ext_vector_type(2))); typedef __bf16 bf16x2_t __attribute__((ext_vector_type(2)));
__device__ __forceinline__ unsigned cvt_pk_bf16(float lo, float hi) { f32x2_t v = {lo, hi}; bf16x2_t b = __builtin_convertvector(v, bf16x2_t); return __builtin_bit_cast(unsigned, b); }
__device__ __forceinline__ float silu_f(float v) { return v * __builtin_amdgcn_rcpf(1.0f + __builtin_amdgcn_exp2f(-1.4426950408889634f * v)); }

struct EpiProj {
    static constexpr bool PERM = true, AFTER_DRAIN = false;
    bf16_t* O; int ldc; unsigned scale_mask, silu_mask; float scale; bf16_t* O2; int ldc2, pm_split, pn_split;
    __device__ __forceinline__ void operator()(const f32x4 (&acc)[2][2][4][2], const Unit& u, int wr, int wc, int fr, int fq) const {
        int row0 = u.pm * BM + wr * 64 + fr, colt = u.pn * BM; bf16_t* base = O; int ld = ldc; unsigned smask = scale_mask, gmask = silu_mask;
        if (u.pm >= pm_split) { row0 -= pm_split * BM; colt -= pn_split * BM; base = O2; ld = ldc2; smask = 0u; gmask = 0u; }
        const int col0 = colt + wc * 32 + 8 * fq;
#pragma unroll
        for (int bj = 0; bj < 2; ++bj) {
            const int blk = (colt >> 7) + bj; const bool do_scale = (smask >> blk) & 1u, do_silu = (gmask >> blk) & 1u; const float sc = do_scale ? scale : 1.0f;
#pragma unroll
            for (int ai = 0; ai < 2; ++ai)
#pragma unroll
                for (int m = 0; m < 4; ++m) { bf16_t* rowp = base + (size_t)(row0 + ai * HALF + m * 16) * ld + col0 + bj * HALF;
                    f32x4 v0 = acc[ai][bj][m][0], v1 = acc[ai][bj][m][1];
                    if (do_silu) { v0 = (f32x4){silu_f(v0[0]), silu_f(v0[1]), silu_f(v0[2]), silu_f(v0[3])}; v1 = (f32x4){silu_f(v1[0]), silu_f(v1[1]), silu_f(v1[2]), silu_f(v1[3])}; }
                    v0 = v0 * sc; v1 = v1 * sc; u32x4 w; w.x = cvt_pk_bf16(v0[0], v0[1]); w.y = cvt_pk_bf16(v0[2], v0[3]); w.z = cvt_pk_bf16(v1[0], v1[1]); w.w = cvt_pk_bf16(v1[2], v1[3]);
                    *(u32x4*)rowp = w; }
        }
    }
};
struct EpiRes {
    static constexpr bool PERM = false, AFTER_DRAIN = false;
    const float* base; float* out; int ldc;
    __device__ __forceinline__ void operator()(const f32x4 (&acc)[2][2][4][2], const Unit& u, int wr, int wc, int fr, int fq) const {
        const int col0 = u.pn * BM + wc * 32 + 4 * fq;
#pragma unroll
        for (int ai = 0; ai < 2; ++ai)
#pragma unroll
            for (int m = 0; m < 4; ++m) { const size_t off = (size_t)(u.pm * BM + ai * HALF + wr * 64 + m * 16 + fr) * ldc + col0;
#pragma unroll
                for (int bj = 0; bj < 2; ++bj)
#pragma unroll
                    for (int n = 0; n < 2; ++n) { const f32x4 bs = *(const f32x4*)(base + off + bj * HALF + n * 16); *(f32x4*)(out + off + bj * HALF + n * 16) = bs + acc[ai][bj][m][n]; } }
    }
};
struct ProjOrder {
    int nM, nN, nwg, ntot, G, c, pm_x, pn_x;
    __device__ void init(int M, int N, int G_, int c_, int extra, int pmx, int pnx) { nM = M / BM; nN = N / BM; nwg = nM * nN; ntot = nwg + extra; G = G_; c = c_; pm_x = pmx; pn_x = pnx; }
    __device__ bool next(int i, Unit& u) const {
        const long L = (long)i * G + c; if (L >= ntot) return false;
        if (L >= nwg) { const int k = (int)L - nwg; u.pm = pm_x + (k & 7); u.pn = pn_x + (k >> 3); return true; }
        int wgid = (int)L; { const int q = nwg / NXCD, r = nwg % NXCD, xcd = wgid % NXCD, off = wgid / NXCD; wgid = (xcd < r ? xcd * (q + 1) : r * (q + 1) + (xcd - r) * q) + off; }
        const int nig = WGM * nN, gid = wgid / nig, fm = gid * WGM, gsz = (nM - fm) < WGM ? (nM - fm) : WGM;
        u.pm = fm + ((wgid % nig) % gsz); u.pn = (wgid % nig) / gsz; return true;
    }
    __device__ __forceinline__ void a_ready(const Unit&) const {}
    __device__ __forceinline__ void done(const Unit&) const {}
};
template <class Epi, class Sched, bool ALIGN_EPI = false, bool SP2 = false>
__device__ __forceinline__ void gemm_phase(PG8_LAS unsigned char* lds, const Gemm g, const Sched& S, const Epi& E) {
    const int tid = threadIdx.x, wid = __builtin_amdgcn_readfirstlane(tid >> 6), lane = tid & 63, wr = wid >> 2, wc = wid & 3, fr = lane & 15, fq = lane >> 4;
    const int K = g.K, nt = K / BK;
    unsigned voffA[2], voffB[2];
#pragma unroll
    for (int i = 0; i < 2; ++i) { int R, C; stage_rc(tid * 16 + i * 8192, R, C); const int Rb = Epi::PERM ? ((R & ~31) + perm32(R & 31)) : R;
        voffA[i] = (unsigned)(R * K + C) * 2u; voffB[i] = (unsigned)(Rb * K + C) * 2u; }
    const size_t kstep = (size_t)(BK * 2);
    const size_t hstep = (size_t)HALF * K * 2;
    const size_t tstep = 2 * hstep;
    const unsigned ldsw = (unsigned)wid * 1024u;
    const int aoff = lds_byte(wr * 64 + fr, fq * 8), boff = lds_byte(wc * 32 + fr, fq * 8);
#define PG8_SA(b, h) (((b) * 2 + (h)) * HTB)
#define PG8_SB(b, h) ((4 + (b) * 2 + (h)) * HTB)
#define PG8_STAGE(bufoff, gbase, voff) do { _Pragma("unroll") for (int _i = 0; _i < 2; ++_i) \
        __builtin_amdgcn_global_load_lds((const unsigned*)((const char*)(gbase) + (voff)[_i]), (PG8_LAS unsigned*)(lds + (bufoff) + ldsw + _i * 8192), 16, 0, 0); } while (0)
#define PG8_LDA(dst, b, h) do { _Pragma("unroll") for (int m = 0; m < 4; ++m) _Pragma("unroll") for (int k = 0; k < 2; ++k) dst[m][k] = *(const PG8_LAS bf16x8*)(lds + PG8_SA(b, h) + aoff + m * 2048 + k * 1024); } while (0)
#define PG8_LDB(dst, b, h) do { _Pragma("unroll") for (int n = 0; n < 2; ++n) _Pragma("unroll") for (int k = 0; k < 2; ++k) dst[n][k] = *(const PG8_LAS bf16x8*)(lds + PG8_SB(b, h) + boff + n * 2048 + k * 1024); } while (0)
#define PG8_MMA(ai, bj, At, Bt) do { __builtin_amdgcn_s_setprio(1); _Pragma("unroll") for (int m = 0; m < 4; ++m) _Pragma("unroll") for (int n = 0; n < 2; ++n) _Pragma("unroll") for (int k = 0; k < 2; ++k) \
        acc[ai][bj][m][n] = __builtin_amdgcn_mfma_f32_16x16x32_bf16(Bt[n][k], At[m][k], acc[ai][bj][m][n], 0, 0, 0); __builtin_amdgcn_s_setprio(0); } while (0)
#define PG8_WAIT_V(n) asm volatile("s_waitcnt vmcnt(" #n ")" ::: "memory")
#define PG8_WAIT_L(n) asm volatile("s_waitcnt lgkmcnt(" #n ")" ::: "memory")
#define PG8_BAR __builtin_amdgcn_s_barrier()
#define PG8_SCHED __builtin_amdgcn_sched_barrier(0)
    Unit cur, nxt; int ui = 0;
    if (!S.next(0, cur)) return;
    f32x4 acc[2][2][4][2];
#pragma unroll
    for (int a = 0; a < 2; ++a)
#pragma unroll
        for (int b = 0; b < 2; ++b)
#pragma unroll
            for (int m = 0; m < 4; ++m)
#pragma unroll
                for (int n = 0; n < 2; ++n) acc[a][b][m][n] = (f32x4){0.f, 0.f, 0.f, 0.f};
    bf16x8 At[4][2], B0[2][2], B1[2][2];
    const char* cA = (const char*)g.A + (size_t)cur.pm * tstep; const char* cB = (const char*)g.Bt + (size_t)cur.pn * tstep;
    S.a_ready(cur);
    if constexpr (SP2) {
        PG8_STAGE(PG8_SB(0, 0), cB, voffB); PG8_STAGE(PG8_SB(0, 1), cB + hstep, voffB); PG8_STAGE(PG8_SA(0, 0), cA, voffA); PG8_STAGE(PG8_SA(0, 1), cA + hstep, voffA);
        if (wr == 1) PG8_BAR;
        PG8_WAIT_V(2); PG8_BAR;
        PG8_STAGE(PG8_SB(1, 0), cB + kstep, voffB); PG8_STAGE(PG8_SA(1, 0), cA + kstep, voffA); PG8_STAGE(PG8_SB(1, 1), cB + hstep + kstep, voffB);
        PG8_WAIT_V(6); PG8_BAR;
    } else {
        PG8_STAGE(PG8_SB(0, 0), cB, voffB); PG8_STAGE(PG8_SA(0, 0), cA, voffA); PG8_STAGE(PG8_SB(0, 1), cB + hstep, voffB); PG8_STAGE(PG8_SA(0, 1), cA + hstep, voffA);
        if (wr == 1) PG8_BAR;
        PG8_WAIT_V(4); PG8_BAR;
        PG8_STAGE(PG8_SB(1, 0), cB + kstep, voffB); PG8_STAGE(PG8_SA(1, 0), cA + kstep, voffA); PG8_STAGE(PG8_SB(1, 1), cB + hstep + kstep, voffB);
        PG8_WAIT_V(6); PG8_BAR;
    }
    for (;;) {
        const bool has_next = S.next(ui + 1, nxt);
        const char* nA = has_next ? (const char*)g.A + (size_t)nxt.pm * tstep : cA; const char* nB = has_next ? (const char*)g.Bt + (size_t)nxt.pn * tstep : cB;
        for (int t = 0; t < nt; t += 2) {
            const bool last = (t == nt - 2);
            const char* a1 = cA + (size_t)(t + 1) * kstep;
            const char* a2 = last ? nA : cA + (size_t)(t + 2) * kstep; const char* b2 = last ? nB : cB + (size_t)(t + 2) * kstep;
            const char* a3 = a2 + kstep; const char* b3 = b2 + kstep;
            if (last && has_next) S.a_ready(nxt);
            if constexpr (SP2) {
            PG8_LDB(B0, 0, 0); PG8_LDB(B1, 0, 1); PG8_SCHED; PG8_LDA(At, 0, 0); PG8_STAGE(PG8_SA(1, 1), a1 + hstep, voffA);
            PG8_WAIT_V(8); PG8_WAIT_L(0); PG8_BAR; PG8_MMA(0, 0, At, B0); PG8_MMA(0, 1, At, B1); PG8_BAR; PG8_SCHED;
            PG8_LDA(At, 0, 1); PG8_STAGE(PG8_SB(0, 0), b2, voffB); PG8_STAGE(PG8_SB(0, 1), b2 + hstep, voffB); PG8_STAGE(PG8_SA(0, 0), a2, voffA);
            PG8_WAIT_V(8); PG8_WAIT_L(0); PG8_BAR; PG8_MMA(1, 0, At, B0); PG8_MMA(1, 1, At, B1); PG8_BAR; PG8_SCHED;
            PG8_LDB(B0, 1, 0); PG8_LDB(B1, 1, 1); PG8_SCHED; PG8_LDA(At, 1, 0); PG8_STAGE(PG8_SA(0, 1), a2 + hstep, voffA);
            PG8_WAIT_V(8); PG8_WAIT_L(0); PG8_BAR; PG8_MMA(0, 0, At, B0); PG8_MMA(0, 1, At, B1); PG8_BAR; PG8_SCHED;
            PG8_LDA(At, 1, 1); PG8_STAGE(PG8_SB(1, 0), b3, voffB); PG8_STAGE(PG8_SB(1, 1), b3 + hstep, voffB); PG8_STAGE(PG8_SA(1, 0), a3, voffA);
            PG8_WAIT_V(8); PG8_WAIT_L(0); PG8_BAR; PG8_MMA(1, 0, At, B0); PG8_MMA(1, 1, At, B1); PG8_BAR; PG8_SCHED;
            } else {
            PG8_LDB(B0, 0, 0); PG8_SCHED; PG8_LDA(At, 0, 0); PG8_STAGE(PG8_SA(1, 1), a1 + hstep, voffA);
            PG8_WAIT_L(8); PG8_BAR; PG8_WAIT_L(0); PG8_MMA(0, 0, At, B0); PG8_BAR; PG8_SCHED;
            PG8_LDB(B1, 0, 1); PG8_STAGE(PG8_SB(0, 0), b2, voffB);
            PG8_BAR; PG8_WAIT_L(0); PG8_MMA(0, 1, At, B1); PG8_BAR;
            PG8_LDA(At, 0, 1); PG8_STAGE(PG8_SA(0, 0), a2, voffA);
            PG8_BAR; PG8_WAIT_L(0); PG8_MMA(1, 0, At, B0); PG8_BAR; PG8_SCHED;
            PG8_STAGE(PG8_SB(0, 1), b2 + hstep, voffB);
            PG8_WAIT_V(6); PG8_BAR; PG8_MMA(1, 1, At, B1); PG8_BAR;
            PG8_LDB(B0, 1, 0); PG8_SCHED; PG8_LDA(At, 1, 0); PG8_STAGE(PG8_SA(0, 1), a2 + hstep, voffA);
            PG8_WAIT_L(8); PG8_BAR; PG8_WAIT_L(0); PG8_MMA(0, 0, At, B0); PG8_BAR; PG8_SCHED;
            PG8_LDB(B1, 1, 1); PG8_STAGE(PG8_SB(1, 0), b3, voffB);
            PG8_BAR; PG8_WAIT_L(0); PG8_MMA(0, 1, At, B1); PG8_BAR;
            PG8_LDA(At, 1, 1); PG8_STAGE(PG8_SA(1, 0), a3, voffA);
            PG8_BAR; PG8_WAIT_L(0); PG8_MMA(1, 0, At, B0); PG8_BAR; PG8_SCHED;
            PG8_STAGE(PG8_SB(1, 1), b3 + hstep, voffB);
            PG8_WAIT_V(6); PG8_BAR; PG8_MMA(1, 1, At, B1); PG8_BAR;
            }
        }
        if constexpr (ALIGN_EPI) { if (wr == 0) PG8_BAR; }
        if constexpr (!Epi::AFTER_DRAIN) { E(acc, cur, wr, wc, fr, fq); S.done(cur); }
        if (!has_next) break;
#pragma unroll
        for (int a = 0; a < 2; ++a)
#pragma unroll
            for (int b = 0; b < 2; ++b)
#pragma unroll
                for (int m = 0; m < 4; ++m)
#pragma unroll
                    for (int n = 0; n < 2; ++n) acc[a][b][m][n] = (f32x4){0.f, 0.f, 0.f, 0.f};
        cur = nxt; cA = nA; cB = nB; ++ui;
        if constexpr (ALIGN_EPI) { if (wr == 1) PG8_BAR; }
    }
    PG8_WAIT_V(0);
    if constexpr (!ALIGN_EPI) { if (wr == 0) PG8_BAR; }
    PG8_BAR;
    if constexpr (Epi::AFTER_DRAIN) { E.fused(acc, cur, wr, wc, fr, fq, lds, wid, lane); S.done(cur); }
#undef PG8_SA
#undef PG8_SB
#undef PG8_STAGE
#undef PG8_LDA
#undef PG8_LDB
#undef PG8_MMA
#undef PG8_WAIT_V
#undef PG8_WAIT_L
#undef PG8_BAR
#undef PG8_SCHED
}
}

namespace att {
using bf16x8 = __attribute__((ext_vector_type(8))) short;
using s16x4 = __attribute__((ext_vector_type(4))) short;
using f32x16 = __attribute__((ext_vector_type(16))) float;
using u32x4 = __attribute__((ext_vector_type(4))) unsigned;
typedef unsigned short bf16_t;
#define ATT_LAS __attribute__((address_space(3)))
typedef ATT_LAS const char* lds_cptr;
typedef short v4i16_t __attribute__((ext_vector_type(4)));
constexpr float LOG2E = 1.4426950408889634f;
constexpr float C2 = 0.125f * LOG2E;
constexpr int LDS_WS = 98304, LDS_TAB = 100352, LDS_OST = 49152, LDS_END = 116736;
constexpr float THR = 8.0f;

__device__ __forceinline__ int crow(int r, int hi) { return (r & 3) + 8 * (r >> 2) + 4 * hi; }
__device__ __forceinline__ void glds16(const void* gsrc, unsigned lds_dst) { unsigned keep;
    asm volatile("s_mov_b32 %0, m0\n\ts_mov_b32 m0, %2\n\ts_nop 0\n\tglobal_load_lds_dwordx4 %1, off\n\ts_mov_b32 m0, %0" : "=&s"(keep) : "v"(gsrc), "s"(lds_dst) : "memory"); }
typedef float f32x2_t __attribute__((ext_vector_type(2))); typedef __bf16 bf16x2_t __attribute__((ext_vector_type(2)));
__device__ __forceinline__ unsigned cvtpk(float lo, float hi) { f32x2_t v = {lo, hi}; bf16x2_t b = __builtin_convertvector(v, bf16x2_t); return __builtin_bit_cast(unsigned, b); }
__device__ __forceinline__ float bflo(unsigned w) { return __uint_as_float(w << 16); }
__device__ __forceinline__ float bfhi(unsigned w) { return __uint_as_float(w & 0xffff0000u); }
__device__ __forceinline__ s16x4 vtr(lds_cptr p) { return __builtin_bit_cast(s16x4, __builtin_amdgcn_ds_read_tr16_b64_v4i16((ATT_LAS v4i16_t*)p)); }
#define ATT_MX3(a, b, c) __builtin_fmaxf(__builtin_fmaxf((a), (b)), (c))
__device__ __forceinline__ float rowmax(const f32x16& p0, const f32x16& p1) {
    float a = ATT_MX3(p0[0], p0[1], p1[0]), b = ATT_MX3(p0[2], p0[3], p1[1]); a = ATT_MX3(a, p1[2], p1[3]);
#pragma unroll
    for (int r = 4; r < 16; r += 4) { a = ATT_MX3(a, p0[r], p0[r + 1]); b = ATT_MX3(b, p0[r + 2], p0[r + 3]); a = ATT_MX3(a, p1[r], p1[r + 1]); b = ATT_MX3(b, p1[r + 2], p1[r + 3]); }
    float m = __builtin_fmaxf(a, b); auto rr = __builtin_amdgcn_permlane32_swap(__float_as_uint(m), __float_as_uint(m), false, false);
    return __builtin_fmaxf(__uint_as_float(rr[0]), __uint_as_float(rr[1])); }
__device__ __forceinline__ float halfsum(float v) { auto rr = __builtin_amdgcn_permlane32_swap(__float_as_uint(v), __float_as_uint(v), false, false); return __uint_as_float(rr[0]) + __uint_as_float(rr[1]); }
__device__ __forceinline__ int t5_bucket(int rel) {
    const int n = rel < 0 ? -rel : rel;
    const int b = n < 8 ? n : (n < 12 ? 8 : (n < 16 ? 9 : (n < 23 ? 10 : (n < 32 ? 11 : (n < 46 ? 12 : (n < 64 ? 13 : (n < 91 ? 14 : 15)))))));
    return b + (rel > 0 ? 16 : 0); }

struct UnitD {
    const bf16_t* Q; const bf16_t* Q2;
    const bf16_t* K; const bf16_t* K2; const bf16_t* V;
    bf16_t* O; const bf16_t* G;
    int qp, kp, op, gp;
    int t_lo, t_hi;
    int q0;
    int head; float sink2;
};

#define ATT_WAIT_BAR(N) asm volatile("s_waitcnt vmcnt(" #N ") lgkmcnt(0)\n\ts_barrier" ::: "memory")
#define ATT_MFMA(a, b, c) __builtin_amdgcn_mfma_f32_32x32x16_bf16(a, b, c, 0, 0, 0)

template <int MODE>
__device__ __forceinline__ void attn_unit(const UnitD& d, char* lds, const float* __restrict__ relb, const float* __restrict__ subg, float lam, float sub_scale) {
    constexpr int DV = (MODE == 3) ? 128 : 64, ND0 = DV / 32, SLOTB = (MODE == 3) ? 32768 : 16384, VOFF = (MODE == 3) ? 16384 : 8192;
    constexpr bool HASBIAS = (MODE == 0 || MODE == 3); constexpr int TOFF = (MODE == 3) ? 2048 : 512;
    int tid = threadIdx.x; asm volatile("" : "+v"(tid));
    const int lane = tid & 63, r32 = lane & 31, hi = lane >> 5; const int wid = __builtin_amdgcn_readfirstlane(tid >> 6);
    const int qblk = (MODE == 3) ? (wid & 3) : wid, stream = (MODE == 3) ? (wid >> 2) : 0;
    const unsigned lds0 = (unsigned)(uintptr_t)lds;
    const lds_cptr l3 = (lds_cptr)lds;
    ATT_LAS float* wsf = (ATT_LAS float*)(l3 + LDS_WS) + wid * 64;
    ATT_LAS float* tab = (ATT_LAS float*)(l3 + LDS_TAB);
    const bf16_t* ksrc = d.K + (long)lane * d.kp + wid * 8;
    const bf16_t* k2src = (MODE == 3) ? d.K2 + (long)lane * d.kp + wid * 8 : nullptr;
    const bf16_t* vsrc = d.V + (long)(16 * (wid & 3) + (lane >> 2)) * d.kp + (wid >> 2) * 32 + (lane & 3) * 8;
    const unsigned kdst = lds0 + wid * 1024, vdst = lds0 + VOFF + wid * 1024;
    const long tstep = (long)64 * d.kp;
#define ATT_DMA(t, slot) do { const unsigned so_ = (unsigned)(slot); \
        glds16(ksrc + (long)(t) * tstep, (unsigned)__builtin_amdgcn_readfirstlane(kdst + so_)); \
        if (MODE == 3) glds16(k2src + (long)(t) * tstep, (unsigned)__builtin_amdgcn_readfirstlane(kdst + 8192u + so_)); \
        glds16(vsrc + (long)(t) * tstep, (unsigned)__builtin_amdgcn_readfirstlane(vdst + so_)); \
        if (MODE == 3) glds16(vsrc + (long)(t) * tstep + 64, (unsigned)__builtin_amdgcn_readfirstlane(vdst + 8192u + so_)); } while (0)
    const int t_lo = d.t_lo, t_hi = d.t_hi;
    ATT_DMA(t_lo, 0);
    if (t_lo + 1 <= t_hi) ATT_DMA(t_lo + 1, SLOTB);
    const bf16_t* Qw = ((MODE == 3 && stream == 1) ? d.Q2 : d.Q) + (long)(qblk * 32 + r32) * d.qp + hi * 8;
    bf16x8 qr[4];
#pragma unroll
    for (int d0 = 0; d0 < 4; ++d0) qr[d0] = *reinterpret_cast<const bf16x8*>(Qw + d0 * 16);
    if (HASBIAS) {
        if (MODE == 3) { for (int i = tid; i < 4096; i += 512) { const int rel = i - 2048; tab[i] = relb[t5_bucket(rel) * 6 + d.head] * LOG2E; } }
        else { for (int i = tid; i < 1024; i += 512) { const int rel = i - 512; const int ar = rel < 0 ? -rel : rel; tab[i] = (ar <= 128) ? relb[t5_bucket(rel) * 6 + d.head] * LOG2E : -1e30f; } }
    }
    const int q0w = d.q0 + qblk * 32;
    int tw_lo = t_lo, tw_hi = t_hi;
    if (MODE == 0) { const int a = (q0w + 1024 - 128) / 64 - 16, b = (q0w + 159) / 64; tw_lo = a > t_lo ? a : t_lo; tw_hi = b < t_hi ? b : t_hi; }
    float mhat = 0.f, l_reg = 0.f; f32x16 o[ND0];
#pragma unroll
    for (int i = 0; i < ND0; ++i) o[i] = f32x16{};
    f32x16 negm = f32x16{};
    bool first = true;
    const lds_cptr kp0 = l3 + stream * 8192 + hi * 1024 + r32 * 16;
    const lds_cptr vp0 = l3 + VOFF + ((lane >> 4) & 1) * 32 + (lane & 3) * 8 + (4 * hi + ((lane & 15) >> 2)) * 64;
    int slot = 0;
    for (int t = t_lo; t <= t_hi; ++t) {
        if (t + 1 <= t_hi) { if (MODE == 3) ATT_WAIT_BAR(4); else ATT_WAIT_BAR(2); } else ATT_WAIT_BAR(0);
        if (t + 2 <= t_hi) { const int s2 = (slot >= SLOTB) ? slot - SLOTB : slot + 2 * SLOTB; ATT_DMA(t + 2, s2); }
        if (t >= tw_lo && t <= tw_hi) {
            f32x16 p0, p1;
            { const lds_cptr kb = kp0 + slot;
#pragma unroll
              for (int d0 = 0; d0 < 4; ++d0) {
                  const bf16x8 b0 = *(const ATT_LAS bf16x8*)(kb + d0 * 2048), b1 = *(const ATT_LAS bf16x8*)(kb + d0 * 2048 + 512);
                  if (d0 == 0) { p0 = ATT_MFMA(b0, qr[0], negm); p1 = ATT_MFMA(b1, qr[0], negm); }
                  else { p0 = ATT_MFMA(b0, qr[d0], p0); p1 = ATT_MFMA(b1, qr[d0], p1); } } }
            if (HASBIAS) { const ATT_LAS float* tb = tab + (64 * t - q0w - r32 + 4 * hi + TOFF);
#pragma unroll
                for (int r = 0; r < 16; ++r) { p0[r] += tb[(r & 3) + 8 * (r >> 2)]; p1[r] += tb[32 + (r & 3) + 8 * (r >> 2)]; } }
            const float rm = rowmax(p0, p1);
            if (first) {
                float dl = rm; if (MODE == 0) dl = __builtin_fmaxf(rm, d.sink2);
                mhat = dl;
#pragma unroll
                for (int r = 0; r < 16; ++r) { p0[r] -= dl; p1[r] -= dl; negm[r] = -mhat; }
                if (MODE == 0) l_reg = (hi == 0) ? __builtin_amdgcn_exp2f(d.sink2 - mhat) : 0.f;
                first = false;
            } else if (__any(rm > THR)) {
                const float dl = __builtin_fmaxf(rm, 0.f); mhat += dl;
#pragma unroll
                for (int r = 0; r < 16; ++r) { p0[r] -= dl; p1[r] -= dl; negm[r] = -mhat; }
                const float f = __builtin_amdgcn_exp2f(-dl); l_reg *= f;
                if (hi == 0) wsf[r32] = f;
                asm volatile("s_waitcnt lgkmcnt(0)" ::: "memory");
#pragma unroll
                for (int r = 0; r < 16; ++r) { const float fr = wsf[crow(r, hi)];
#pragma unroll
                    for (int i = 0; i < ND0; ++i) o[i][r] *= fr; }
            }
            float sacc = 0.f;
#pragma unroll
            for (int r = 0; r < 16; ++r) { p0[r] = __builtin_amdgcn_exp2f(p0[r]); p1[r] = __builtin_amdgcn_exp2f(p1[r]); sacc += p0[r] + p1[r]; }
            l_reg += sacc;
            const u32x4 pw0 = {cvtpk(p0[0], p0[1]), cvtpk(p0[2], p0[3]), cvtpk(p0[4], p0[5]), cvtpk(p0[6], p0[7])};
            const u32x4 pw1 = {cvtpk(p0[8], p0[9]), cvtpk(p0[10], p0[11]), cvtpk(p0[12], p0[13]), cvtpk(p0[14], p0[15])};
            const u32x4 pw2 = {cvtpk(p1[0], p1[1]), cvtpk(p1[2], p1[3]), cvtpk(p1[4], p1[5]), cvtpk(p1[6], p1[7])};
            const u32x4 pw3 = {cvtpk(p1[8], p1[9]), cvtpk(p1[10], p1[11]), cvtpk(p1[12], p1[13]), cvtpk(p1[14], p1[15])};
            const lds_cptr vb = vp0 + slot;
#pragma unroll
            for (int d0 = 0; d0 < ND0; ++d0) {
                if (ND0 > 2) asm volatile("" ::: "memory");
#define ATT_VF(ks) ({ const s16x4 lo_ = vtr(vb + d0 * 4096 + (ks) * 1024), hi_ = vtr(vb + d0 * 4096 + (ks) * 1024 + 512); (bf16x8){lo_[0], lo_[1], lo_[2], lo_[3], hi_[0], hi_[1], hi_[2], hi_[3]}; })
                o[d0] = ATT_MFMA(__builtin_bit_cast(bf16x8, pw0), ATT_VF(0), o[d0]);
                o[d0] = ATT_MFMA(__builtin_bit_cast(bf16x8, pw1), ATT_VF(1), o[d0]);
                o[d0] = ATT_MFMA(__builtin_bit_cast(bf16x8, pw2), ATT_VF(2), o[d0]);
                o[d0] = ATT_MFMA(__builtin_bit_cast(bf16x8, pw3), ATT_VF(3), o[d0]);
#undef ATT_VF
            }
        }
        slot = (slot == 2 * SLOTB) ? 0 : slot + SLOTB;
    }
    int lane_e = lane; asm volatile("" : "+v"(lane_e));
    l_reg = halfsum(l_reg);
    if (MODE != 3) {
        if (hi == 0) wsf[32 + r32] = l_reg;
        asm volatile("s_waitcnt lgkmcnt(0)" ::: "memory");
        ATT_LAS bf16_t* stg = (ATT_LAS bf16_t*)(l3 + LDS_OST) + wid * 2048;
#pragma unroll
        for (int r = 0; r < 16; ++r) { const int orow = crow(r, hi); const float rl = __builtin_amdgcn_rcpf(wsf[32 + orow]);
#pragma unroll
            for (int d0 = 0; d0 < 2; ++d0) { const unsigned w = cvtpk(o[d0][r] * rl, 0.f); stg[orow * 64 + d0 * 32 + r32] = (bf16_t)(w & 0xffffu); } }
        asm volatile("s_waitcnt lgkmcnt(0)" ::: "memory");
        bf16_t* Ow = d.O + (long)(qblk * 32) * d.op; const bf16_t* Gw = d.G + (long)(qblk * 32) * d.gp;
#pragma unroll
        for (int i = 0; i < 4; ++i) { const int row = i * 8 + (lane_e >> 3), ch = lane_e & 7;
            const u32x4 v = *(const ATT_LAS u32x4*)(stg + row * 64 + ch * 8); const u32x4 g = *(const u32x4*)(Gw + (long)row * d.gp + ch * 8);
            u32x4 w; w.x = cvtpk(bflo(v.x) * bflo(g.x), bfhi(v.x) * bfhi(g.x)); w.y = cvtpk(bflo(v.y) * bflo(g.y), bfhi(v.y) * bfhi(g.y));
            w.z = cvtpk(bflo(v.z) * bflo(g.z), bfhi(v.z) * bfhi(g.z)); w.w = cvtpk(bflo(v.w) * bflo(g.w), bfhi(v.w) * bfhi(g.w));
            *(u32x4*)(Ow + (long)row * d.op + ch * 8) = w; }
        asm volatile("s_waitcnt vmcnt(0) lgkmcnt(0)\n\ts_barrier" ::: "memory");
    } else {
        asm volatile("s_waitcnt vmcnt(0) lgkmcnt(0)\n\ts_barrier" ::: "memory");
        ATT_LAS float* X = (ATT_LAS float*)l3 + qblk * 4096;
        if (hi == 0) wsf[32 + r32] = (stream == 0) ? __builtin_amdgcn_rcpf(l_reg) : lam * __builtin_amdgcn_rcpf(l_reg);
        asm volatile("s_waitcnt lgkmcnt(0)" ::: "memory");
#pragma unroll
        for (int r = 0; r < 16; ++r) { const float fr = wsf[32 + crow(r, hi)];
#pragma unroll
            for (int i = 0; i < ND0; ++i) o[i][r] *= fr; }
        if (stream == 1) {
#pragma unroll
            for (int i = 0; i < ND0; ++i)
#pragma unroll
                for (int r = 0; r < 16; ++r) X[(i * 16 + r) * 64 + lane] = o[i][r];
        }
        asm volatile("s_waitcnt lgkmcnt(0)\n\ts_barrier" ::: "memory");
        if (stream == 0) {
            float ss[16];
#pragma unroll
            for (int r = 0; r < 16; ++r) ss[r] = 0.f;
#pragma unroll
            for (int i = 0; i < ND0; ++i)
#pragma unroll
                for (int r = 0; r < 16; ++r) { o[i][r] -= X[(i * 16 + r) * 64 + lane]; ss[r] += o[i][r] * o[i][r]; }
            asm volatile("s_waitcnt lgkmcnt(0)" ::: "memory");
#pragma unroll
            for (int r = 0; r < 16; ++r) {
#pragma unroll
                for (int off = 1; off < 32; off <<= 1) ss[r] += __shfl_xor(ss[r], off);
                ss[r] = __builtin_amdgcn_rsqf(ss[r] * (1.0f / 128.0f) + 1e-6f) * sub_scale; }
            ATT_LAS bf16_t* stg = (ATT_LAS bf16_t*)X;
#pragma unroll
            for (int i = 0; i < ND0; ++i) { const float gsub = subg[i * 32 + r32];
#pragma unroll
                for (int r = 0; r < 16; ++r) { const unsigned w = cvtpk(o[i][r] * ss[r] * gsub, 0.f); stg[crow(r, hi) * 128 + i * 32 + r32] = (bf16_t)(w & 0xffffu); } }
            asm volatile("s_waitcnt lgkmcnt(0)" ::: "memory");
            bf16_t* Ow = d.O + (long)(qblk * 32) * d.op; const bf16_t* Gw = d.G + (long)(qblk * 32) * d.gp;
#pragma unroll
            for (int i = 0; i < 8; ++i) { const int piece = i * 64 + lane_e, row = piece >> 4, ch = piece & 15;
                const u32x4 v = *(const ATT_LAS u32x4*)(stg + row * 128 + ch * 8); const u32x4 g = *(const u32x4*)(Gw + (long)row * d.gp + ch * 8);
                u32x4 w; w.x = cvtpk(bflo(v.x) * bflo(g.x), bfhi(v.x) * bfhi(g.x)); w.y = cvtpk(bflo(v.y) * bflo(g.y), bfhi(v.y) * bfhi(g.y));
                w.z = cvtpk(bflo(v.z) * bflo(g.z), bfhi(v.z) * bfhi(g.z)); w.w = cvtpk(bflo(v.w) * bflo(g.w), bfhi(v.w) * bfhi(g.w));
                *(u32x4*)(Ow + (long)row * d.op + ch * 8) = w; }
        }
        asm volatile("s_waitcnt vmcnt(0) lgkmcnt(0)\n\ts_barrier" ::: "memory");
    }
#undef ATT_DMA
}
}

constexpr int NWAVES = 8;
#ifndef MK_ONE_LAUNCH
#define MK_ONE_LAUNCH 1
#endif
constexpr int NPHASE = 10;

constexpr int BATCH = 8, SEQ = 2048, D = 1024, MEM = 256;
constexpr int M = BATCH * SEQ;
constexpr int MM = BATCH * MEM;
constexpr int N0 = 2560, N1 = 3584;
constexpr float EPS = 1e-6f;
constexpr float LAM_INIT = 0.35550906759096934f;
constexpr int L0_AQ = 0, L0_AK = 384, L0_AV = 512, L0_BQ = 640, L0_BK = 1024, L0_BV = 1152, L0_XQ = 1280, L0_G = 1536;
constexpr int L1_Q1 = 0, L1_Q2 = 384, L1_K1 = 768, L1_K2 = 1152, L1_V = 1536, L1_XQ = 2304, L1_G = 2560;

constexpr size_t MiB = 1u << 20;
constexpr size_t WS_CTL = 0, CTL_ZERO_BYTES = 1 * MiB;
constexpr size_t WS_W0 = 2 * MiB;
constexpr size_t WS_WM = WS_W0 + (size_t)N0 * D * 2;
constexpr size_t WS_WO0 = WS_WM + (size_t)1024 * D * 2;
constexpr size_t WS_W1 = WS_WO0 + (size_t)D * D * 2;
constexpr size_t WS_WO1 = WS_W1 + (size_t)N1 * D * 2;
constexpr size_t WS_XN = 24 * MiB;
constexpr size_t WS_MN = WS_XN + (size_t)M * D * 2;
constexpr size_t WS_MKV = WS_MN + (size_t)MM * D * 2;
constexpr size_t WS_Y = WS_MKV + (size_t)MM * 1024 * 2;
constexpr size_t WS_PR = WS_Y + (size_t)M * D * 2;
constexpr size_t WS_END = WS_PR + (size_t)M * N1 * 2;
static_assert(WS_WO1 + (size_t)D * D * 2 <= WS_XN && WS_END <= 256 * MiB, "d_ws map");
constexpr int CW_BAR = 4096;

constexpr int RING_OFF = 0, RING_BYTES = 131072;
constexpr int LDSCTL_OFF = RING_BYTES, MISC_OFF = LDSCTL_OFF + 320;
constexpr int LDS_BYTES = 147456;
static_assert(MISC_OFF + 128 <= LDS_BYTES && att::LDS_END <= RING_BYTES, "LDS map");

#define GAS __attribute__((address_space(1)))
#define LAS __attribute__((address_space(3)))
typedef unsigned short bf16;
typedef unsigned v4u __attribute__((ext_vector_type(4)));
typedef float f32x4 __attribute__((ext_vector_type(4)));
typedef GAS unsigned gu32;
#define RLX_AGENT __ATOMIC_RELAXED, __HIP_MEMORY_SCOPE_AGENT
#define LDS_WAIT() asm volatile("s_waitcnt lgkmcnt(0)" ::: "memory")
#define VM_WAIT() asm volatile("s_waitcnt vmcnt(0)" ::: "memory")
__device__ __forceinline__ unsigned pk2(float lo, float hi) { return pg8::cvt_pk_bf16(lo, hi); }

#define XB_TMO      128
#define XB_XCNT(j)  (256  + 64 * (j))
#define XB_XSUB(j)  (1280 + 64 * (j))
#define XB_XGEN(j)  (2304 + 64 * (j))
#define XB_TOP      3328
#define XB_TOPGEN   3392
#define XCD_BAR_WORDS 3456
#define XB_SPIN_CAP (1u << 18)

__device__ __forceinline__ unsigned xb_ld(unsigned* p)              { return __hip_atomic_load(p, __ATOMIC_RELAXED, __HIP_MEMORY_SCOPE_AGENT); }
__device__ __forceinline__ unsigned xb_add(unsigned* p, unsigned v) { return __hip_atomic_fetch_add(p, v, __ATOMIC_RELAXED, __HIP_MEMORY_SCOPE_AGENT); }
__device__ __forceinline__ unsigned xb_xcc_id() { return (unsigned)__builtin_amdgcn_s_getreg((3 << 11) | 20) & 0xFu; }
#define XB_SPIN(cond, bar) do { unsigned _sp = 0; while (cond) { __builtin_amdgcn_s_sleep(1); \
    if ((++_sp & 255u) == 0u) { if (xb_ld(&(bar)[XB_TMO])) break; if (_sp > XB_SPIN_CAP) { atomicAdd(&(bar)[XB_TMO], 1u); break; } } } } while (0)

struct XcdBarrier {
    unsigned* bar; unsigned x;
    volatile LAS unsigned* st;
};

__device__ __forceinline__ XcdBarrier xcd_barrier_post(unsigned* bar, volatile LAS unsigned* st) {
    XcdBarrier b; b.bar = bar; b.x = xb_xcc_id(); b.st = st;
    if (threadIdx.x == 0) (void)xb_add(&bar[XB_XCNT(b.x)], 1u);
    return b;
}
__device__ __forceinline__ void xcd_barrier_complete(unsigned* bar, unsigned x, unsigned& nloc, unsigned& nx) {
    const unsigned G = gridDim.x * gridDim.y * gridDim.z;
    unsigned sum, cnt, mine, sp = 0u;
    for (;;) {
        sum = 0u; cnt = 0u; mine = 0u;
#pragma unroll
        for (unsigned j = 0; j < 16; ++j) { const unsigned c = xb_ld(&bar[XB_XCNT(j)]); sum += c; cnt += (c > 0u) ? 1u : 0u; mine = (j == x) ? c : mine; }
        if (sum == G) break;
        __builtin_amdgcn_s_sleep(1);
        if ((++sp & 255u) == 0u) { if (xb_ld(&bar[XB_TMO])) break; if (sp > XB_SPIN_CAP) { atomicAdd(&bar[XB_TMO], 1u); break; } }
    }
    nloc = mine > 0u ? mine : 1u; nx = cnt > 0u ? cnt : 1u;
}

__device__ __forceinline__ void xcd_barrier(const XcdBarrier& b) {
    asm volatile("s_waitcnt vmcnt(0)" ::: "memory");
    __syncthreads();
    if (threadIdx.x == 0) {
        unsigned* bar = b.bar;
        __builtin_amdgcn_s_waitcnt(0);
        unsigned nloc = b.st[0], nx = b.st[1];
        if (nloc == 0u) { xcd_barrier_complete(bar, b.x, nloc, nx); b.st[0] = nloc; b.st[1] = nx; }
        const unsigned old = xb_add(&bar[XB_XSUB(b.x)], 1u);
        const unsigned gen = old / nloc;
        if (old + 1u == (gen + 1u) * nloc) {
            __builtin_amdgcn_fence(__ATOMIC_RELEASE, "agent");
            asm volatile("s_waitcnt vmcnt(0)" ::: "memory");
            const unsigned og = xb_add(&bar[XB_TOP], 1u);
            const unsigned tg = og / nx;
            if (og + 1u == (tg + 1u) * nx) xb_add(&bar[XB_TOPGEN], 1u);
            else XB_SPIN(xb_ld(&bar[XB_TOPGEN]) == tg, bar);
            __builtin_amdgcn_fence(__ATOMIC_ACQUIRE, "agent");
            xb_add(&bar[XB_XGEN(b.x)], 1u);
            asm volatile("s_waitcnt vmcnt(0)" ::: "memory");
        } else {
            XB_SPIN(xb_ld(&bar[XB_XGEN(b.x)]) == gen, bar);
            __builtin_amdgcn_fence(__ATOMIC_ACQUIRE, "agent");
            asm volatile("s_waitcnt vmcnt(0)" ::: "memory");
        }
    }
    __syncthreads();
}


struct Frame {
    LAS unsigned char* lds;
    volatile LAS unsigned* MISC;
    gu32* ctl;
    int tid, lane, wave;
    int vcu, G;
};

__device__ __forceinline__ float wave_sum(float v) {
#pragma unroll
    for (int o = 1; o < 64; o <<= 1) v += __shfl_xor(v, o);
    return v;
}
__device__ __forceinline__ void p0_transpose_item(const float* W, int K, int N, bf16* WT, int row_off, LAS float* scr, int item, int lane) {
    const int nblk = N / 32, kb = item / nblk, nb = item % nblk, k0 = 64 * kb, n0 = 32 * nb;
#pragma unroll 8
    for (int i = 0; i < 32; ++i) { const int kk = 2 * i + (lane >> 5); scr[kk * 33 + (lane & 31)] = W[(size_t)(k0 + kk) * N + n0 + (lane & 31)]; }
    LDS_WAIT(); asm volatile("" ::: "memory");
    const int c = lane & 7;
#pragma unroll
    for (int j = 0; j < 4; ++j) { const int n = (lane >> 3) + 8 * j; const LAS float* s = scr + (8 * c) * 33 + n;
        v4u o; o.x = pk2(s[0 * 33], s[1 * 33]); o.y = pk2(s[2 * 33], s[3 * 33]); o.z = pk2(s[4 * 33], s[5 * 33]); o.w = pk2(s[6 * 33], s[7 * 33]);
        *(GAS v4u*)(WT + (size_t)(row_off + n0 + n) * K + k0 + 8 * c) = o; }
    LDS_WAIT(); asm volatile("" ::: "memory");
}
__device__ __forceinline__ void rms_row_to_bf16(int lane, const float* xrow, const float* g, bf16* orow) {
    const GAS f32x4* xr = (const GAS f32x4*)xrow + lane; const GAS f32x4* gr = (const GAS f32x4*)g + lane;
    f32x4 v[4]; float s = 0.f;
#pragma unroll
    for (int j = 0; j < 4; ++j) { v[j] = xr[64 * j]; s += (v[j].x * v[j].x + v[j].y * v[j].y) + (v[j].z * v[j].z + v[j].w * v[j].w); }
    const float rstd = __builtin_amdgcn_rsqf(wave_sum(s) * (1.f / D) + EPS);
    GAS unsigned long long* o8 = (GAS unsigned long long*)orow + lane;
#pragma unroll
    for (int j = 0; j < 4; ++j) { const f32x4 gg = gr[64 * j];
        o8[64 * j] = (unsigned long long)pk2(v[j].x * rstd * gg.x, v[j].y * rstd * gg.y) | ((unsigned long long)pk2(v[j].z * rstd * gg.z, v[j].w * rstd * gg.w) << 32); }
}
__device__ __forceinline__ void rms_row_inplace(int lane, float* xrow, const float* g) {
    GAS f32x4* xr = (GAS f32x4*)xrow + lane; const GAS f32x4* gr = (const GAS f32x4*)g + lane;
    f32x4 v[4]; float s = 0.f;
#pragma unroll
    for (int j = 0; j < 4; ++j) { v[j] = xr[64 * j]; s += (v[j].x * v[j].x + v[j].y * v[j].y) + (v[j].z * v[j].z + v[j].w * v[j].w); }
    const float rstd = __builtin_amdgcn_rsqf(wave_sum(s) * (1.f / D) + EPS);
#pragma unroll
    for (int j = 0; j < 4; ++j) { const f32x4 gg = gr[64 * j]; xr[64 * j] = v[j] * rstd * gg; }
}

struct Args { const float* in[21]; float* out; unsigned char* ws; int ph_lo, ph_hi; };

__device__ __forceinline__ void normrope_row(int lane, bf16* prow, int pos, const float* qn, const float* kn) {
    const int hh = lane >> 3, j = lane & 7;
    bf16* p = prow + (hh < 6 ? L0_BQ + hh * 64 : L0_BK + (hh - 6) * 64) + 8 * j;
    const v4u raw = *(const GAS v4u*)p;
    float x[8]; x[0] = att::bflo(raw.x); x[1] = att::bfhi(raw.x); x[2] = att::bflo(raw.y); x[3] = att::bfhi(raw.y); x[4] = att::bflo(raw.z); x[5] = att::bfhi(raw.z); x[6] = att::bflo(raw.w); x[7] = att::bfhi(raw.w);
    float ss = 0.f;
#pragma unroll
    for (int e = 0; e < 8; ++e) ss += x[e] * x[e];
    ss += __shfl_xor(ss, 1); ss += __shfl_xor(ss, 2); ss += __shfl_xor(ss, 4);
    const float rstd = __builtin_amdgcn_rsqf(ss * (1.f / 64.f) + EPS);
    const float* gn = (hh < 6 ? qn : kn) + 8 * j;
    const float posax = (float)((j < 4) ? (pos >> 6) : (pos & 63));
    const bool is_x2 = (j & 2) != 0;
    float y[8];
#pragma unroll
    for (int e = 0; e < 8; ++e) y[e] = x[e] * rstd * gn[e];
    float outv[8];
#pragma unroll
    for (int e = 0; e < 8; ++e) {
        const float other = __shfl_xor(y[e], 2);
        const int fi = 8 * (j & 1) + e;
        const float inv = __builtin_amdgcn_exp2f(-(float)fi * (13.287712379549449f / 16.0f));
        const float ang = posax * inv; const float c = __cosf(ang), s = __sinf(ang);
        outv[e] = is_x2 ? (other * s + y[e] * c) : (y[e] * c - other * s);
    }
    const float sc = (hh < 6) ? att::C2 : 1.0f;
    v4u w; w.x = pk2(outv[0] * sc, outv[1] * sc); w.y = pk2(outv[2] * sc, outv[3] * sc); w.z = pk2(outv[4] * sc, outv[5] * sc); w.w = pk2(outv[6] * sc, outv[7] * sc);
    *(GAS v4u*)p = w;
}

__global__ void __launch_bounds__(NWAVES * 64, 2) mk_fwd(Args args) {
    extern __shared__ __attribute__((aligned(16))) unsigned char lds[];
    Frame F;
    F.lds = (LAS unsigned char*)lds;
    F.MISC = (volatile LAS unsigned*)(F.lds + MISC_OFF);
    F.tid = threadIdx.x; F.lane = F.tid & 63; F.wave = __builtin_amdgcn_readfirstlane(F.tid >> 6);
    F.G = gridDim.x; { const int bx = blockIdx.x; F.vcu = (F.G % 8 == 0) ? (bx % 8) * (F.G / 8) + bx / 8 : bx; }
    unsigned char* ws = args.ws;
    F.ctl = (gu32*)(ws + WS_CTL);
    const float* x = args.in[0]; const float* mem = args.in[1]; const float* relb = args.in[2]; const float* mem_norm = args.in[3]; const float* final_norm = args.in[4];
    const float* even_norm = args.in[5]; const float* even_w_in = args.in[6]; const float* even_sink = args.in[7]; const float* even_qn = args.in[8]; const float* even_kn = args.in[9];
    const float* even_wmkv = args.in[10]; const float* even_wout = args.in[11]; const float* odd_norm = args.in[12]; const float* odd_w_in = args.in[13];
    const float* lq1 = args.in[14]; const float* lk1 = args.in[15]; const float* lq2 = args.in[16]; const float* lk2 = args.in[17]; const float* odd_subln = args.in[18];
    const float* odd_wmkv = args.in[19]; const float* odd_wout = args.in[20];
    float* out = args.out;
    bf16* W0t = (bf16*)(ws + WS_W0); bf16* Wmt = (bf16*)(ws + WS_WM); bf16* Wo0t = (bf16*)(ws + WS_WO0); bf16* W1t = (bf16*)(ws + WS_W1); bf16* Wo1t = (bf16*)(ws + WS_WO1);
    bf16* XN = (bf16*)(ws + WS_XN); bf16* MN = (bf16*)(ws + WS_MN); bf16* MKV = (bf16*)(ws + WS_MKV); bf16* Y = (bf16*)(ws + WS_Y); bf16* PR = (bf16*)(ws + WS_PR);

    for (int u = F.tid; u < (LDS_BYTES - LDSCTL_OFF) / 4; u += NWAVES * 64) ((LAS unsigned*)(F.lds + LDSCTL_OFF))[u] = 0u;
    __syncthreads();
    XcdBarrier bar; bar.bar = (unsigned*)(F.ctl + CW_BAR); bar.x = 0; bar.st = nullptr;
    const int lo = args.ph_lo, hi = args.ph_hi;
    if (hi - lo > 1) bar = xcd_barrier_post((unsigned*)(F.ctl + CW_BAR), F.MISC + 8);
#ifndef PH_MASK
#define PH_MASK 0x3ff
#endif
#define IN(k) (((PH_MASK >> (k)) & 1) && lo <= (k) && (k) < hi)
#define SEAM(k) do { if (IN(k) && IN((k) + 1)) xcd_barrier(bar); } while (0)
    const int gw = F.vcu * NWAVES + F.wave, NGW = F.G * NWAVES;

    if (IN(0)) {
        LAS float* scr = (LAS float*)(F.lds + RING_OFF + F.wave * 16384);
        constexpr int I_W0 = 16 * (N0 / 32), I_MK = 16 * (512 / 32), I_WO = 16 * (D / 32), I_W1 = 16 * (N1 / 32);
        constexpr int NITEMS = I_W0 + 2 * I_MK + 2 * I_WO + I_W1;
        for (int it = gw; it < NITEMS; it += NGW) {
            int r = it;
            if (r < I_W0) { p0_transpose_item(even_w_in, D, N0, W0t, 0, scr, r, F.lane); continue; } r -= I_W0;
            if (r < I_MK) { p0_transpose_item(even_wmkv, D, 512, Wmt, 0, scr, r, F.lane); continue; } r -= I_MK;
            if (r < I_MK) { p0_transpose_item(odd_wmkv, D, 512, Wmt, 512, scr, r, F.lane); continue; } r -= I_MK;
            if (r < I_WO) { p0_transpose_item(even_wout, D, D, Wo0t, 0, scr, r, F.lane); continue; } r -= I_WO;
            if (r < I_W1) { p0_transpose_item(odd_w_in, D, N1, W1t, 0, scr, r, F.lane); continue; } r -= I_W1;
            p0_transpose_item(odd_wout, D, D, Wo1t, 0, scr, r, F.lane);
        }
        for (int m = gw; m < M + MM; m += NGW) {
            if (m < M) rms_row_to_bf16(F.lane, x + (size_t)m * D, even_norm, XN + (size_t)m * D);
            else rms_row_to_bf16(F.lane, mem + (size_t)(m - M) * D, mem_norm, MN + (size_t)(m - M) * D);
        }
    }
    SEAM(0);
    if (IN(1)) {
        pg8::Gemm g{XN, W0t, M + MM, N0 + 1024, D}; pg8::ProjOrder S; S.init(M, N0, F.G, (int)blockIdx.x, 32, M / 256, N0 / 256);
        pg8::EpiProj E{PR, N0, 0x00000C07u, 0x000FF000u, att::C2, MKV, 1024, M / 256, N0 / 256};
        pg8::gemm_phase<pg8::EpiProj, pg8::ProjOrder, true, true>(F.lds + RING_OFF, g, S, E);
    }
    SEAM(1);
    if (IN(2)) {
        for (int m = gw; m < M; m += NGW) normrope_row(F.lane, PR + (size_t)m * N0, m & (SEQ - 1), even_qn, even_kn);
    }
    SEAM(2);
    if (IN(3)) {
        const int nslots = (F.G == 256) ? 6 : (1024 + F.G - 1) / F.G;
        for (int i = 0; i < nslots; ++i) {
            int kind = -1, b = 0, u = 0;
            if (F.G == 256) { b = F.vcu >> 5; const int j = F.vcu & 31;
                if (j < 16) { if (i < 2) { kind = 1; u = 2 * j + i; } }
                else { const int k = j - 16; if (i == 0) { kind = 1; u = 32 + k; } else if (i < 4) { kind = 0; u = 3 * k + (i - 1); } else { kind = 2; u = 2 * k + (i - 4); } } }
            else { const int L = i * F.G + (int)blockIdx.x; if (L < 384) { kind = 1; b = L / 48; u = L % 48; } else if (L < 768) { kind = 0; b = (L - 384) / 48; u = (L - 384) % 48; } else if (L < 1024) { kind = 2; b = (L - 768) / 32; u = (L - 768) % 32; } }
            if (kind < 0) continue;
            const int h = u >> 3, qb = u & 7, q0 = qb * 256; const size_t row0 = (size_t)b * SEQ;
            att::UnitD d; d.qp = N0; d.op = D; d.gp = N0; d.q0 = q0; d.Q2 = nullptr; d.K2 = nullptr; d.head = h; d.sink2 = 0.f;
            const bf16* prq = PR + (row0 + q0) * N0; const bf16* prk = PR + row0 * N0;
            if (kind == 0) { const int kvh = h / 3; d.Q = prq + L0_AQ + h * 64; d.K = prk + L0_AK + kvh * 64; d.V = prk + L0_AV + kvh * 64; d.kp = N0;
                d.O = Y + (row0 + q0) * D + h * 64; d.G = prq + L0_G + h * 64; d.sink2 = even_sink[h] * att::LOG2E;
                const int tl = q0 / 64 - 2, th = q0 / 64 + 5; d.t_lo = tl < 0 ? 0 : tl; d.t_hi = th > 31 ? 31 : th;
                att::attn_unit<0>(d, (char*)lds + RING_OFF, relb, nullptr, 0.f, 0.f); }
            else if (kind == 1) { const int kvh = h / 3; d.Q = prq + L0_BQ + h * 64; d.K = prk + L0_BK + kvh * 64; d.V = prk + L0_BV + kvh * 64; d.kp = N0;
                d.O = Y + (row0 + q0) * D + 384 + h * 64; d.G = prq + L0_G + 384 + h * 64; d.t_lo = 0; d.t_hi = 31;
                att::attn_unit<1>(d, (char*)lds + RING_OFF, relb, nullptr, 0.f, 0.f); }
            else { const bf16* mk = MKV + (size_t)b * MEM * 1024; d.Q = prq + L0_XQ + h * 64; d.K = mk + h * 64; d.V = mk + 256 + h * 64; d.kp = 1024;
                d.O = Y + (row0 + q0) * D + 768 + h * 64; d.G = prq + L0_G + 768 + h * 64; d.t_lo = 0; d.t_hi = 3;
                att::attn_unit<2>(d, (char*)lds + RING_OFF, relb, nullptr, 0.f, 0.f); }
        }
    }
    SEAM(3);
    if (IN(4)) {
        pg8::Gemm g{Y, Wo0t, M, D, D}; pg8::ProjOrder S; S.init(M, D, F.G, (int)blockIdx.x, 0, 0, 0);
        pg8::EpiRes E{x, out, D};
        pg8::gemm_phase<pg8::EpiRes, pg8::ProjOrder, false, true>(F.lds + RING_OFF, g, S, E);
    }
    SEAM(4);
    if (IN(5)) {
        for (int m = gw; m < M; m += NGW) rms_row_to_bf16(F.lane, out + (size_t)m * D, odd_norm, XN + (size_t)m * D);
    }
    SEAM(5);
    if (IN(6)) {
        pg8::Gemm g{XN, W1t, M, N1, D}; pg8::ProjOrder S; S.init(M, N1, F.G, (int)blockIdx.x, 0, 0, 0);
        pg8::EpiProj E{PR, N1, 0x000C003Fu, 0x0FF00000u, att::C2, nullptr, 0, 1 << 20, 0};
        pg8::gemm_phase<pg8::EpiProj, pg8::ProjOrder, true, true>(F.lds + RING_OFF, g, S, E);
    }
    SEAM(6);
    if (IN(7)) {
        float lam;
        { const float a = lq1[F.lane] * lk1[F.lane], c = lq2[F.lane] * lk2[F.lane]; lam = __expf(wave_sum(a)) - __expf(wave_sum(c)) + LAM_INIT; }
        const int nslots = (F.G == 256) ? 4 : (1024 + F.G - 1) / F.G;
        for (int i = 0; i < nslots; ++i) {
            int kind = -1, b = 0, h = 0, qb = 0;
            if (F.G == 256) { b = F.vcu >> 5; const int j = F.vcu & 31; if (i < 3) { kind = 3; h = 2 * i + (j >> 4); qb = j & 15; } else { kind = 2; h = j >> 3; qb = j & 7; } }
            else { const int L = i * F.G + (int)blockIdx.x; if (L < 768) { kind = 3; b = L / 96; h = (L % 96) / 16; qb = L % 16; } else if (L < 1024) { kind = 2; b = (L - 768) / 32; h = ((L - 768) % 32) / 8; qb = L % 8; } }
            if (kind < 0) continue;
            const size_t row0 = (size_t)b * SEQ;
            att::UnitD d; d.qp = N1; d.op = D; d.gp = N1; d.Q2 = nullptr; d.K2 = nullptr; d.head = h; d.sink2 = 0.f;
            if (kind == 3) { const int q0 = qb * 128; const bf16* prq = PR + (row0 + q0) * N1; const bf16* prk = PR + row0 * N1; d.q0 = q0;
                d.Q = prq + L1_Q1 + h * 64; d.Q2 = prq + L1_Q2 + h * 64; d.K = prk + L1_K1 + h * 64; d.K2 = prk + L1_K2 + h * 64; d.V = prk + L1_V + h * 128; d.kp = N1;
                d.O = Y + (row0 + q0) * D + h * 128; d.G = prq + L1_G + h * 128; d.t_lo = 0; d.t_hi = 31;
                att::attn_unit<3>(d, (char*)lds + RING_OFF, relb, odd_subln, lam, 1.0f - LAM_INIT); }
            else { const int q0 = qb * 256; const bf16* prq = PR + (row0 + q0) * N1; d.q0 = q0; const bf16* mk = MKV + (size_t)b * MEM * 1024;
                d.Q = prq + L1_XQ + h * 64; d.K = mk + 512 + h * 64; d.V = mk + 768 + h * 64; d.kp = 1024;
                d.O = Y + (row0 + q0) * D + 768 + h * 64; d.G = prq + L1_G + 768 + h * 64; d.t_lo = 0; d.t_hi = 3;
                att::attn_unit<2>(d, (char*)lds + RING_OFF, relb, nullptr, 0.f, 0.f); }
        }
    }
    SEAM(7);
    if (IN(8)) {
        pg8::Gemm g{Y, Wo1t, M, D, D}; pg8::ProjOrder S; S.init(M, D, F.G, (int)blockIdx.x, 0, 0, 0);
        pg8::EpiRes E{out, out, D};
        pg8::gemm_phase<pg8::EpiRes, pg8::ProjOrder, false, true>(F.lds + RING_OFF, g, S, E);
    }
    SEAM(8);
    if (IN(9)) {
        for (int m = gw; m < M; m += NGW) rms_row_inplace(F.lane, out + (size_t)m * D, final_norm);
    }
#undef IN
#undef SEAM
}

extern "C" void kernel_launch(void* const* d_in, const int* in_sizes, int n_in, void* d_out, int out_size, void* d_ws, size_t ws_size, hipStream_t stream) {
    static int grid = 0;
    if (grid == 0) {
        if (n_in != 21 || in_sizes[0] != M * D || out_size != M * D || ws_size < WS_END) { fprintf(stderr, "kernel_launch: unexpected shapes (n_in %d, in0 %d, out %d, ws %zu); nothing launched\n", n_in, n_in > 0 ? in_sizes[0] : -1, out_size, ws_size); grid = -1; return; }
        int dev = 0, cus = 0, per_cu = 0;
        if (hipGetDevice(&dev) != hipSuccess || hipDeviceGetAttribute(&cus, hipDeviceAttributeMultiprocessorCount, dev) != hipSuccess) { grid = -1; return; }
        if (hipFuncSetAttribute((const void*)mk_fwd, hipFuncAttributeMaxDynamicSharedMemorySize, LDS_BYTES) != hipSuccess) { fprintf(stderr, "kernel_launch: hipFuncSetAttribute failed\n"); grid = -1; return; }
        if (hipOccupancyMaxActiveBlocksPerMultiprocessor(&per_cu, (const void*)mk_fwd, NWAVES * 64, LDS_BYTES) != hipSuccess || per_cu < 1) { fprintf(stderr, "kernel_launch: occupancy query reports %d blocks per CU\n", per_cu); (void)hipGetLastError(); grid = -1; return; }
        grid = cus;
    }
    if (grid < 0) return;
    (void)hipMemsetAsync((char*)d_ws + WS_CTL, 0, CTL_ZERO_BYTES, stream);
    Args a{};
    for (int i = 0; i < 21; ++i) a.in[i] = (const float*)d_in[i];
    a.out = (float*)d_out; a.ws = (unsigned char*)d_ws;
#if MK_ONE_LAUNCH
    a.ph_lo = 0; a.ph_hi = NPHASE;
    void* kargs[] = {&a};
    hipError_t e = hipLaunchCooperativeKernel((const void*)mk_fwd, dim3(grid), dim3(NWAVES * 64), kargs, LDS_BYTES, stream);
    if (e != hipSuccess) fprintf(stderr, "kernel_launch: cooperative launch failed: %s (grid %d)\n", hipGetErrorString(e), grid);
#else
    for (int p = 0; p < NPHASE; ++p) { a.ph_lo = p; a.ph_hi = p + 1; hipLaunchKernelGGL(mk_fwd, dim3(grid), dim3(NWAVES * 64), LDS_BYTES, stream, a); }
#endif
}
```

```cpp
#include <hip/hip_runtime.h>
#include <cstdio>
#include <cstdint>
namespace pg8 {
#define PG8_LAS __attribute__((address_space(3)))
typedef unsigned short bf16_t;
typedef short bf16x8 __attribute__((ext_vector_type(8)));
typedef float f32x4 __attribute__((ext_vector_type(4)));
typedef unsigned u32x4 __attribute__((ext_vector_type(4)));
constexpr int BM = 256, BK = 64, HALF = 128, HTB = HALF * BK * 2  , STAGE_BYTES = 8 * HTB, NXCD = 8, WGM = 8;

__host__ __device__ __forceinline__ int lds_byte(int r, int c) { const int st = (r >> 4) * 2 + (c >> 5), rr = r & 15, cc = c & 31, ob = rr * 64 + cc * 2; return st * 1024 + (ob ^ (((ob >> 9) & 1) << 5)); }
__host__ __device__ __forceinline__ void stage_rc(int b, int& R, int& C) { const int st = b / 1024, sb = b % 1024, swz = sb ^ (((sb >> 9) & 1) << 5); R = (st >> 1) * 16 + swz / 64; C = (st & 1) * 32 + (swz % 64) / 2; }
__host__ __device__ __forceinline__ int perm32(int rho) { const int n = rho >> 4, i = rho & 15; return 8 * (i >> 2) + 4 * n + (i & 3); }

struct Unit { int pm, pn; };
struct Gemm { const bf16_t* A; const bf16_t* Bt; int M, N, K; };

struct StaticOrder {
    int nM, nN, nwg, G, c;
    __host__ __device__ void init(int M, int N, int G_, int c_) { nM = M / BM; nN = N / BM; nwg = nM * nN; G = G_; c = c_; }
    __host__ __device__ bool next(int i, Unit& u) const {
        const long L = (long)i * G + c; if (L >= nwg) return false;
        int wgid = (int)L; { const int q = nwg / NXCD, r = nwg % NXCD, xcd = wgid % NXCD, off = wgid / NXCD; wgid = (xcd < r ? xcd * (q + 1) : r * (q + 1) + (xcd - r) * q) + off; }
        const int nig = WGM * nN, gid = wgid / nig, fm = gid * WGM, gsz = (nM - fm) < WGM ? (nM - fm) : WGM;
        u.pm = fm + ((wgid % nig) % gsz); u.pn = (wgid % nig) / gsz; return true;
    }
    __device__ __forceinline__ void a_ready(const Unit&) const {}
    __device__ __forceinline__ void done(const Unit&) const {}
};


typedef float f32x2_t __attribute__((ext_vector_type(2))); typedef __bf16 bf16x2_t __attribute__((ext_vector_type(2)));
__device__ __forceinline__ unsigned cvt_pk_bf16(float lo, float hi) { f32x2_t v = {lo, hi}; bf16x2_t b = __builtin_convertvector(v, bf16x2_t); return __builtin_bit_cast(unsigned, b); }
__device__ __forceinline__ float silu_f(float v) { return v * __builtin_amdgcn_rcpf(1.0f + __builtin_amdgcn_exp2f(-1.4426950408889634f * v)); }

struct EpiProj {
    static constexpr bool PERM = true, AFTER_DRAIN = false;
    bf16_t* O; int ldc; unsigned scale_mask, silu_mask; float scale; bf16_t* O2; int ldc2, pm_split, pn_split;
    __device__ __forceinline__ void operator()(const f32x4 (&acc)[2][2][4][2], const Unit& u, int wr, int wc, int fr, int fq) const {
        int row0 = u.pm * BM + wr * 64 + fr, colt = u.pn * BM; bf16_t* base = O; int ld = ldc; unsigned smask = scale_mask, gmask = silu_mask;
        if (u.pm >= pm_split) { row0 -= pm_split * BM; colt -= pn_split * BM; base = O2; ld = ldc2; smask = 0u; gmask = 0u; }
        const int col0 = colt + wc * 32 + 8 * fq;
#pragma unroll
        for (int bj = 0; bj < 2; ++bj) {
            const int blk = (colt >> 7) + bj; const bool do_scale = (smask >> blk) & 1u, do_silu = (gmask >> blk) & 1u; const float sc = do_scale ? scale : 1.0f;
#pragma unroll
            for (int ai = 0; ai < 2; ++ai)
#pragma unroll
                for (int m = 0; m < 4; ++m) { bf16_t* rowp = base + (size_t)(row0 + ai * HALF + m * 16) * ld + col0 + bj * HALF;
                    f32x4 v0 = acc[ai][bj][m][0], v1 = acc[ai][bj][m][1];
                    if (do_silu) { v0 = (f32x4){silu_f(v0[0]), silu_f(v0[1]), silu_f(v0[2]), silu_f(v0[3])}; v1 = (f32x4){silu_f(v1[0]), silu_f(v1[1]), silu_f(v1[2]), silu_f(v1[3])}; }
                    v0 = v0 * sc; v1 = v1 * sc; u32x4 w; w.x = cvt_pk_bf16(v0[0], v0[1]); w.y = cvt_pk_bf16(v0[2], v0[3]); w.z = cvt_pk_bf16(v1[0], v1[1]); w.w = cvt_pk_bf16(v1[2], v1[3]);
                    *(u32x4*)rowp = w; }
        }
    }
};
struct EpiRes {
    static constexpr bool PERM = false, AFTER_DRAIN = false;
    const float* base; float* out; int ldc;
    __device__ __forceinline__ void operator()(const f32x4 (&acc)[2][2][4][2], const Unit& u, int wr, int wc, int fr, int fq) const {
        const int col0 = u.pn * BM + wc * 32 + 4 * fq;
#pragma unroll
        for (int ai = 0; ai < 2; ++ai)
#pragma unroll
            for (int m = 0; m < 4; ++m) { const size_t off = (size_t)(u.pm * BM + ai * HALF + wr * 64 + m * 16 + fr) * ldc + col0;
#pragma unroll
                for (int bj = 0; bj < 2; ++bj)
#pragma unroll
                    for (int n = 0; n < 2; ++n) { const f32x4 bs = *(const f32x4*)(base + off + bj * HALF + n * 16); *(f32x4*)(out + off + bj * HALF + n * 16) = bs + acc[ai][bj][m][n]; } }
    }
};
struct ProjOrder {
    int nM, nN, nwg, ntot, G, c, pm_x, pn_x;
    __device__ void init(int M, int N, int G_, int c_, int extra, int pmx, int pnx) { nM = M / BM; nN = N / BM; nwg = nM * nN; ntot = nwg + extra; G = G_; c = c_; pm_x = pmx; pn_x = pnx; }
    __device__ bool next(int i, Unit& u) const {
        const long L = (long)i * G + c; if (L >= ntot) return false;
        if (L >= nwg) { const int k = (int)L - nwg; u.pm = pm_x + (k & 7); u.pn = pn_x + (k >> 3); return true; }
        int wgid = (int)L; { const int q = nwg / NXCD, r = nwg % NXCD, xcd = wgid % NXCD, off = wgid / NXCD; wgid = (xcd < r ? xcd * (q + 1) : r * (q + 1) + (xcd - r) * q) + off; }
        const int nig = WGM * nN, gid = wgid / nig, fm = gid * WGM, gsz = (nM - fm) < WGM ? (nM - fm) : WGM;
        u.pm = fm + ((wgid % nig) % gsz); u.pn = (wgid % nig) / gsz; return true;
    }
    __device__ __forceinline__ void a_ready(const Unit&) const {}
    __device__ __forceinline__ void done(const Unit&) const {}
};
template <class Epi, class Sched, bool ALIGN_EPI = false, bool SP2 = false>
__device__ __forceinline__ void gemm_phase(PG8_LAS unsigned char* lds, const Gemm g, const Sched& S, const Epi& E) {
    int tid = threadIdx.x; asm volatile("" : "+v"(tid));
    const int wid = __builtin_amdgcn_readfirstlane(tid >> 6), lane = tid & 63, wr = wid >> 2, wc = wid & 3, fr = lane & 15, fq = lane >> 4;
    const int K = g.K, nt = K / BK;
    unsigned voffA[2], voffB[2];
#pragma unroll
    for (int i = 0; i < 2; ++i) { int R, C; stage_rc(tid * 16 + i * 8192, R, C); const int Rb = Epi::PERM ? ((R & ~31) + perm32(R & 31)) : R;
        voffA[i] = (unsigned)(R * K + C) * 2u; voffB[i] = (unsigned)(Rb * K + C) * 2u; }
    const size_t kstep = (size_t)(BK * 2);
    const size_t hstep = (size_t)HALF * K * 2;
    const size_t tstep = 2 * hstep;
    const unsigned ldsw = (unsigned)wid * 1024u;
    const int aoff = lds_byte(wr * 64 + fr, fq * 8), boff = lds_byte(wc * 32 + fr, fq * 8);
#define PG8_SA(b, h) (((b) * 2 + (h)) * HTB)
#define PG8_SB(b, h) ((4 + (b) * 2 + (h)) * HTB)
#define PG8_STAGE(bufoff, gbase, voff) do { _Pragma("unroll") for (int _i = 0; _i < 2; ++_i) \
        __builtin_amdgcn_global_load_lds((const unsigned*)((const char*)(gbase) + (voff)[_i]), (PG8_LAS unsigned*)(lds + (bufoff) + ldsw + _i * 8192), 16, 0, 0); } while (0)
#define PG8_LDA(dst, b, h) do { _Pragma("unroll") for (int m = 0; m < 4; ++m) _Pragma("unroll") for (int k = 0; k < 2; ++k) dst[m][k] = *(const PG8_LAS bf16x8*)(lds + PG8_SA(b, h) + aoff + m * 2048 + k * 1024); } while (0)
#define PG8_LDB(dst, b, h) do { _Pragma("unroll") for (int n = 0; n < 2; ++n) _Pragma("unroll") for (int k = 0; k < 2; ++k) dst[n][k] = *(const PG8_LAS bf16x8*)(lds + PG8_SB(b, h) + boff + n * 2048 + k * 1024); } while (0)
#define PG8_MMA(ai, bj, At, Bt) do { __builtin_amdgcn_s_setprio(1); _Pragma("unroll") for (int m = 0; m < 4; ++m) _Pragma("unroll") for (int n = 0; n < 2; ++n) _Pragma("unroll") for (int k = 0; k < 2; ++k) \
        acc[ai][bj][m][n] = __builtin_amdgcn_mfma_f32_16x16x32_bf16(Bt[n][k], At[m][k], acc[ai][bj][m][n], 0, 0, 0); __builtin_amdgcn_s_setprio(0); } while (0)
#define PG8_WAIT_V(n) asm volatile("s_waitcnt vmcnt(" #n ")" ::: "memory")
#define PG8_WAIT_L(n) asm volatile("s_waitcnt lgkmcnt(" #n ")" ::: "memory")
#define PG8_BAR __builtin_amdgcn_s_barrier()
#define PG8_SCHED __builtin_amdgcn_sched_barrier(0)
    Unit cur, nxt; int ui = 0;
    if (!S.next(0, cur)) return;
    f32x4 acc[2][2][4][2];
#pragma unroll
    for (int a = 0; a < 2; ++a)
#pragma unroll
        for (int b = 0; b < 2; ++b)
#pragma unroll
            for (int m = 0; m < 4; ++m)
#pragma unroll
                for (int n = 0; n < 2; ++n) acc[a][b][m][n] = (f32x4){0.f, 0.f, 0.f, 0.f};
    bf16x8 At[4][2], B0[2][2], B1[2][2];
    const char* cA = (const char*)g.A + (size_t)cur.pm * tstep; const char* cB = (const char*)g.Bt + (size_t)cur.pn * tstep;
    S.a_ready(cur);
    if constexpr (SP2) {
        PG8_STAGE(PG8_SB(0, 0), cB, voffB); PG8_STAGE(PG8_SB(0, 1), cB + hstep, voffB); PG8_STAGE(PG8_SA(0, 0), cA, voffA); PG8_STAGE(PG8_SA(0, 1), cA + hstep, voffA);
        if (wr == 1) PG8_BAR;
        PG8_WAIT_V(2); PG8_BAR;
        PG8_STAGE(PG8_SB(1, 0), cB + kstep, voffB); PG8_STAGE(PG8_SA(1, 0), cA + kstep, voffA); PG8_STAGE(PG8_SB(1, 1), cB + hstep + kstep, voffB);
        PG8_WAIT_V(6); PG8_BAR;
    } else {
        PG8_STAGE(PG8_SB(0, 0), cB, voffB); PG8_STAGE(PG8_SA(0, 0), cA, voffA); PG8_STAGE(PG8_SB(0, 1), cB + hstep, voffB); PG8_STAGE(PG8_SA(0, 1), cA + hstep, voffA);
        if (wr == 1) PG8_BAR;
        PG8_WAIT_V(4); PG8_BAR;
        PG8_STAGE(PG8_SB(1, 0), cB + kstep, voffB); PG8_STAGE(PG8_SA(1, 0), cA + kstep, voffA); PG8_STAGE(PG8_SB(1, 1), cB + hstep + kstep, voffB);
        PG8_WAIT_V(6); PG8_BAR;
    }
    for (;;) {
        const bool has_next = S.next(ui + 1, nxt);
        const char* nA = has_next ? (const char*)g.A + (size_t)nxt.pm * tstep : cA; const char* nB = has_next ? (const char*)g.Bt + (size_t)nxt.pn * tstep : cB;
        for (int t = 0; t < nt; t += 2) {
            const bool last = (t == nt - 2);
            const char* a1 = cA + (size_t)(t + 1) * kstep;
            const char* a2 = last ? nA : cA + (size_t)(t + 2) * kstep; const char* b2 = last ? nB : cB + (size_t)(t + 2) * kstep;
            const char* a3 = a2 + kstep; const char* b3 = b2 + kstep;
            if (last && has_next) S.a_ready(nxt);
            if constexpr (SP2) {
            PG8_LDB(B0, 0, 0); PG8_LDB(B1, 0, 1); PG8_SCHED; PG8_LDA(At, 0, 0); PG8_STAGE(PG8_SA(1, 1), a1 + hstep, voffA);
            PG8_WAIT_V(8); PG8_WAIT_L(0); PG8_BAR; PG8_MMA(0, 0, At, B0); PG8_MMA(0, 1, At, B1); PG8_BAR; PG8_SCHED;
            PG8_LDA(At, 0, 1); PG8_STAGE(PG8_SB(0, 0), b2, voffB); PG8_STAGE(PG8_SB(0, 1), b2 + hstep, voffB); PG8_STAGE(PG8_SA(0, 0), a2, voffA);
            PG8_WAIT_V(8); PG8_WAIT_L(0); PG8_BAR; PG8_MMA(1, 0, At, B0); PG8_MMA(1, 1, At, B1); PG8_BAR; PG8_SCHED;
            PG8_LDB(B0, 1, 0); PG8_LDB(B1, 1, 1); PG8_SCHED; PG8_LDA(At, 1, 0); PG8_STAGE(PG8_SA(0, 1), a2 + hstep, voffA);
            PG8_WAIT_V(8); PG8_WAIT_L(0); PG8_BAR; PG8_MMA(0, 0, At, B0); PG8_MMA(0, 1, At, B1); PG8_BAR; PG8_SCHED;
            PG8_LDA(At, 1, 1); PG8_STAGE(PG8_SB(1, 0), b3, voffB); PG8_STAGE(PG8_SB(1, 1), b3 + hstep, voffB); PG8_STAGE(PG8_SA(1, 0), a3, voffA);
            PG8_WAIT_V(8); PG8_WAIT_L(0); PG8_BAR; PG8_MMA(1, 0, At, B0); PG8_MMA(1, 1, At, B1); PG8_BAR; PG8_SCHED;
            } else {
            PG8_LDB(B0, 0, 0); PG8_SCHED; PG8_LDA(At, 0, 0); PG8_STAGE(PG8_SA(1, 1), a1 + hstep, voffA);
            PG8_WAIT_L(8); PG8_BAR; PG8_WAIT_L(0); PG8_MMA(0, 0, At, B0); PG8_BAR; PG8_SCHED;
            PG8_LDB(B1, 0, 1); PG8_STAGE(PG8_SB(0, 0), b2, voffB);
            PG8_BAR; PG8_WAIT_L(0); PG8_MMA(0, 1, At, B1); PG8_BAR;
            PG8_LDA(At, 0, 1); PG8_STAGE(PG8_SA(0, 0), a2, voffA);
            PG8_BAR; PG8_WAIT_L(0); PG8_MMA(1, 0, At, B0); PG8_BAR; PG8_SCHED;
            PG8_STAGE(PG8_SB(0, 1), b2 + hstep, voffB);
            PG8_WAIT_V(6); PG8_BAR; PG8_MMA(1, 1, At, B1); PG8_BAR;
            PG8_LDB(B0, 1, 0); PG8_SCHED; PG8_LDA(At, 1, 0); PG8_STAGE(PG8_SA(0, 1), a2 + hstep, voffA);
            PG8_WAIT_L(8); PG8_BAR; PG8_WAIT_L(0); PG8_MMA(0, 0, At, B0); PG8_BAR; PG8_SCHED;
            PG8_LDB(B1, 1, 1); PG8_STAGE(PG8_SB(1, 0), b3, voffB);
            PG8_BAR; PG8_WAIT_L(0); PG8_MMA(0, 1, At, B1); PG8_BAR;
            PG8_LDA(At, 1, 1); PG8_STAGE(PG8_SA(1, 0), a3, voffA);
            PG8_BAR; PG8_WAIT_L(0); PG8_MMA(1, 0, At, B0); PG8_BAR; PG8_SCHED;
            PG8_STAGE(PG8_SB(1, 1), b3 + hstep, voffB);
            PG8_WAIT_V(6); PG8_BAR; PG8_MMA(1, 1, At, B1); PG8_BAR;
            }
        }
        if constexpr (ALIGN_EPI) { if (wr == 0) PG8_BAR; }
        if constexpr (!Epi::AFTER_DRAIN) { E(acc, cur, wr, wc, fr, fq); S.done(cur); }
        if (!has_next) break;
#pragma unroll
        for (int a = 0; a < 2; ++a)
#pragma unroll
            for (int b = 0; b < 2; ++b)
#pragma unroll
                for (int m = 0; m < 4; ++m)
#pragma unroll
                    for (int n = 0; n < 2; ++n) acc[a][b][m][n] = (f32x4){0.f, 0.f, 0.f, 0.f};
        cur = nxt; cA = nA; cB = nB; ++ui;
        if constexpr (ALIGN_EPI) { if (wr == 1) PG8_BAR; }
    }
    PG8_WAIT_V(0);
    if constexpr (!ALIGN_EPI) { if (wr == 0) PG8_BAR; }
    PG8_BAR;
    if constexpr (Epi::AFTER_DRAIN) { E.fused(acc, cur, wr, wc, fr, fq, lds, wid, lane); S.done(cur); }
#undef PG8_SA
#undef PG8_SB
#undef PG8_STAGE
#undef PG8_LDA
#undef PG8_LDB
#undef PG8_MMA
#undef PG8_WAIT_V
#undef PG8_WAIT_L
#undef PG8_BAR
#undef PG8_SCHED
}
}

namespace att {
#ifndef ATT_PIPE
#define ATT_PIPE 1
#endif
using bf16x8 = __attribute__((ext_vector_type(8))) short;
using s16x4 = __attribute__((ext_vector_type(4))) short;
using f32x16 = __attribute__((ext_vector_type(16))) float;
using u32x4 = __attribute__((ext_vector_type(4))) unsigned;
typedef unsigned short bf16_t;
#define ATT_LAS __attribute__((address_space(3)))
typedef ATT_LAS const char* lds_cptr;
typedef short v4i16_t __attribute__((ext_vector_type(4)));
constexpr float LOG2E = 1.4426950408889634f;
constexpr float C2 = 0.125f * LOG2E;
constexpr int LDS_WS = 98304, LDS_TAB = 100352, LDS_OST = 49152, LDS_END = 116736;
constexpr float THR = 8.0f;

__device__ __forceinline__ int crow(int r, int hi) { return (r & 3) + 8 * (r >> 2) + 4 * hi; }
__device__ __forceinline__ void glds16(const void* gsrc, unsigned lds_dst) { unsigned keep;
    asm volatile("s_mov_b32 %0, m0\n\ts_mov_b32 m0, %2\n\ts_nop 0\n\tglobal_load_lds_dwordx4 %1, off\n\ts_mov_b32 m0, %0" : "=&s"(keep) : "v"(gsrc), "s"(lds_dst) : "memory"); }
typedef float f32x2_t __attribute__((ext_vector_type(2))); typedef __bf16 bf16x2_t __attribute__((ext_vector_type(2)));
__device__ __forceinline__ unsigned cvtpk(float lo, float hi) { f32x2_t v = {lo, hi}; bf16x2_t b = __builtin_convertvector(v, bf16x2_t); return __builtin_bit_cast(unsigned, b); }
__device__ __forceinline__ float bflo(unsigned w) { return __uint_as_float(w << 16); }
__device__ __forceinline__ float bfhi(unsigned w) { return __uint_as_float(w & 0xffff0000u); }
__device__ __forceinline__ s16x4 vtr(lds_cptr p) { return __builtin_bit_cast(s16x4, __builtin_amdgcn_ds_read_tr16_b64_v4i16((ATT_LAS v4i16_t*)p)); }
#define ATT_MX3(a, b, c) __builtin_fmaxf(__builtin_fmaxf((a), (b)), (c))
__device__ __forceinline__ float rowmax(const f32x16& p0, const f32x16& p1) {
    float a = ATT_MX3(p0[0], p0[1], p1[0]), b = ATT_MX3(p0[2], p0[3], p1[1]); a = ATT_MX3(a, p1[2], p1[3]);
#pragma unroll
    for (int r = 4; r < 16; r += 4) { a = ATT_MX3(a, p0[r], p0[r + 1]); b = ATT_MX3(b, p0[r + 2], p0[r + 3]); a = ATT_MX3(a, p1[r], p1[r + 1]); b = ATT_MX3(b, p1[r + 2], p1[r + 3]); }
    float m = __builtin_fmaxf(a, b); auto rr = __builtin_amdgcn_permlane32_swap(__float_as_uint(m), __float_as_uint(m), false, false);
    return __builtin_fmaxf(__uint_as_float(rr[0]), __uint_as_float(rr[1])); }
__device__ __forceinline__ float halfsum(float v) { auto rr = __builtin_amdgcn_permlane32_swap(__float_as_uint(v), __float_as_uint(v), false, false); return __uint_as_float(rr[0]) + __uint_as_float(rr[1]); }
__device__ __forceinline__ int t5_bucket(int rel) {
    const int n = rel < 0 ? -rel : rel;
    const int b = n < 8 ? n : (n < 12 ? 8 : (n < 16 ? 9 : (n < 23 ? 10 : (n < 32 ? 11 : (n < 46 ? 12 : (n < 64 ? 13 : (n < 91 ? 14 : 15)))))));
    return b + (rel > 0 ? 16 : 0); }

struct UnitD {
    const bf16_t* Q; const bf16_t* Q2;
    const bf16_t* K; const bf16_t* K2; const bf16_t* V;
    bf16_t* O; const bf16_t* G;
    int qp, kp, op, gp;
    int t_lo, t_hi;
    int q0;
    int head; float sink2;
};

#define ATT_WAIT_BAR(N) asm volatile("s_waitcnt vmcnt(" #N ") lgkmcnt(0)\n\ts_barrier" ::: "memory")
#define ATT_MFMA(a, b, c) __builtin_amdgcn_mfma_f32_32x32x16_bf16(a, b, c, 0, 0, 0)


#define ATT_SBAR() __builtin_amdgcn_sched_barrier(0)
#define ATT_PIN(x) asm volatile("" : "+v"(x))
#define ATT_KLD(kb, i) (*(const ATT_LAS bf16x8*)((kb) + ((i) >> 1) * 2048 + ((i) & 1) * 512))
template <int ND0> __device__ __forceinline__ bf16x8 att_vld(lds_cptr vb, int j) {
    const int d0 = j % ND0, ks = j / ND0; const s16x4 lo_ = vtr(vb + d0 * 4096 + ks * 1024), hi_ = vtr(vb + d0 * 4096 + ks * 1024 + 512);
    return (bf16x8){lo_[0], lo_[1], lo_[2], lo_[3], hi_[0], hi_[1], hi_[2], hi_[3]}; }
__device__ __forceinline__ void att_qk_plain(f32x16& C0, f32x16& C1, const f32x16& negm, const bf16x8 (&qr)[4], lds_cptr kb) {
#pragma unroll
    for (int d0 = 0; d0 < 4; ++d0) { const bf16x8 b0 = ATT_KLD(kb, 2 * d0), b1 = ATT_KLD(kb, 2 * d0 + 1);
        if (d0 == 0) { C0 = ATT_MFMA(b0, qr[0], negm); C1 = ATT_MFMA(b1, qr[0], negm); } else { C0 = ATT_MFMA(b0, qr[d0], C0); C1 = ATT_MFMA(b1, qr[d0], C1); } }
}
__device__ __forceinline__ void att_bias(f32x16& C0, f32x16& C1, const ATT_LAS float* tb) {
#pragma unroll
    for (int r = 0; r < 16; ++r) { C0[r] += tb[(r & 3) + 8 * (r >> 2)]; C1[r] += tb[32 + (r & 3) + 8 * (r >> 2)]; }
}
template <int ND0>
__device__ __forceinline__ void att_step(f32x16& C0, f32x16& C1, f32x16& P0, f32x16& P1, f32x16 (&o)[ND0], f32x16& ol, const bf16x8& ones, f32x16& negm, const bf16x8 (&qr)[4], float& mhat, const float cfar, bool& resc,
                                         ATT_LAS float* wsf, lds_cptr kb, lds_cptr vb, const bool near, const ATT_LAS float* tb, const int r32, const int hi) {
    constexpr int NPV = 4 * ND0;
    bf16x8 kf[8]; unsigned w[16]; bf16x8 vf[NPV];
    ATT_SBAR();
    kf[0] = ATT_KLD(kb, 0); kf[1] = ATT_KLD(kb, 1); kf[2] = ATT_KLD(kb, 2); kf[3] = ATT_KLD(kb, 3);
    ATT_SBAR();
#pragma unroll
    for (int i = 0; i < 8; ++i) {
        if (i + 4 < 8) kf[i + 4] = ATT_KLD(kb, i + 4);
        if (i >= 4) vf[i - 4] = att_vld<ND0>(vb, i - 4);
#if defined(EXP_QK2)
        { f32x16 dummy_ = ATT_MFMA(kf[i], qr[i >> 1], negm); asm volatile("" :: "v"(dummy_)); }
#endif
        if (i == 0) C0 = ATT_MFMA(kf[0], qr[0], negm); else if (i == 1) C1 = ATT_MFMA(kf[1], qr[0], negm);
        else if (i & 1) C1 = ATT_MFMA(kf[i], qr[i >> 1], C1); else C0 = ATT_MFMA(kf[i], qr[i >> 1], C0);
#pragma unroll
        for (int k = 0; k < 2; ++k) { const int pp = 2 * i + k, idx = 2 * pp; w[pp] = (idx < 16) ? cvtpk(P0[idx & 15], P0[(idx & 15) + 1]) : cvtpk(P1[idx & 15], P1[(idx & 15) + 1]); ATT_PIN(w[pp]); }
        ATT_SBAR();
    }
    if (near) att_bias(C0, C1, tb);
    { const float rm = rowmax(C0, C1); resc = false;
      if (__builtin_expect(__any(rm > THR), 0)) { const float dl = __builtin_fmaxf(rm, 0.f); mhat += dl;
#pragma unroll
          for (int r = 0; r < 16; ++r) { C0[r] -= dl; C1[r] -= dl; negm[r] = cfar - mhat; }
          asm volatile("" : "+v"(negm));
          const float f = __builtin_amdgcn_exp2f(-dl); if (hi == 0) wsf[r32] = f; resc = true; } }
    ATT_SBAR();
    constexpr int NG = NPV + 4;
#pragma unroll
    for (int g = 0; g < NG; ++g) {
        const int ks = g / (ND0 + 1), m = g % (ND0 + 1);
        const u32x4 pwk = {w[4 * ks], w[4 * ks + 1], w[4 * ks + 2], w[4 * ks + 3]};
        if (m < ND0) { const int j = ks * ND0 + m;
            if (j + 4 < NPV) vf[j + 4] = att_vld<ND0>(vb, j + 4);
            o[m] = ATT_MFMA(__builtin_bit_cast(bf16x8, pwk), vf[j], o[m]); }
        else ol = ATT_MFMA(__builtin_bit_cast(bf16x8, pwk), ones, ol);
        const int e0 = (32 * g) / NG, e1 = (32 * (g + 1)) / NG;
#pragma unroll
        for (int idx = e0; idx < e1; ++idx) { if (idx < 16) C0[idx & 15] = __builtin_amdgcn_exp2f(C0[idx & 15]); else C1[idx & 15] = __builtin_amdgcn_exp2f(C1[idx & 15]); }
        if (e0 < 16) ATT_PIN(C0); if (e1 > 16) ATT_PIN(C1);
        ATT_SBAR();
    }
}
template <int ND0>
__device__ __forceinline__ void att_drain(f32x16& P0, f32x16& P1, f32x16 (&o)[ND0], f32x16& ol, const bf16x8& ones, lds_cptr vb) {
    u32x4 pw[4];
#pragma unroll
    for (int pp = 0; pp < 16; ++pp) { const int idx = 2 * pp; pw[pp >> 2][pp & 3] = (idx < 16) ? cvtpk(P0[idx & 15], P0[(idx & 15) + 1]) : cvtpk(P1[idx & 15], P1[(idx & 15) + 1]); }
#pragma unroll
    for (int j = 0; j < 4 * ND0; ++j) o[j % ND0] = ATT_MFMA(__builtin_bit_cast(bf16x8, pw[j / ND0]), att_vld<ND0>(vb, j), o[j % ND0]);
#pragma unroll
    for (int ks = 0; ks < 4; ++ks) ol = ATT_MFMA(__builtin_bit_cast(bf16x8, pw[ks]), ones, ol);
}

template <int MODE>
__device__ __forceinline__ void attn_unit(const UnitD& d, char* lds, const float* __restrict__ relb, const float* __restrict__ subg, float lam, float sub_scale) {
    constexpr int DV = (MODE == 3) ? 128 : 64, ND0 = DV / 32, SLOTB = (MODE == 3) ? 32768 : 16384, VOFF = (MODE == 3) ? 16384 : 8192;
    constexpr bool HASBIAS = (MODE == 0 || MODE == 3); constexpr int TOFF = (MODE == 3) ? 2048 : 512;
    int tid = threadIdx.x; asm volatile("" : "+v"(tid));
    const int lane = tid & 63, r32 = lane & 31, hi = lane >> 5; const int wid = __builtin_amdgcn_readfirstlane(tid >> 6);
    const int qblk = (MODE == 3) ? (wid & 3) : wid, stream = (MODE == 3) ? (wid >> 2) : 0;
    const unsigned lds0 = (unsigned)(uintptr_t)lds;
    const lds_cptr l3 = (lds_cptr)lds;
    ATT_LAS float* wsf = (ATT_LAS float*)(l3 + LDS_WS) + wid * 64;
    ATT_LAS float* tab = (ATT_LAS float*)(l3 + LDS_TAB);
    const bf16_t* ksrc = d.K + (long)lane * d.kp + wid * 8;
    const bf16_t* k2src = (MODE == 3) ? d.K2 + (long)lane * d.kp + wid * 8 : nullptr;
    const bf16_t* vsrc = d.V + (long)(16 * (wid & 3) + (lane >> 2)) * d.kp + (wid >> 2) * 32 + (lane & 3) * 8;
    const unsigned kdst = lds0 + wid * 1024, vdst = lds0 + VOFF + wid * 1024;
    const long tstep = (long)64 * d.kp;
#define ATT_DMA_K(t, slot) do { const unsigned so_ = (unsigned)(slot); \
        glds16(ksrc + (long)(t) * tstep, (unsigned)__builtin_amdgcn_readfirstlane(kdst + so_)); \
        if (MODE == 3) glds16(k2src + (long)(t) * tstep, (unsigned)__builtin_amdgcn_readfirstlane(kdst + 8192u + so_)); } while (0)
#define ATT_DMA_V(t, slot) do { const unsigned so_ = (unsigned)(slot); \
        glds16(vsrc + (long)(t) * tstep, (unsigned)__builtin_amdgcn_readfirstlane(vdst + so_)); \
        if (MODE == 3) glds16(vsrc + (long)(t) * tstep + 64, (unsigned)__builtin_amdgcn_readfirstlane(vdst + 8192u + so_)); } while (0)
#define ATT_DMA(t, slot) do { ATT_DMA_K(t, slot); ATT_DMA_V(t, slot); } while (0)
#if defined(EXP_DMA2)
#define ATT_DMA_K2(t, slot) do { ATT_DMA_K(t, slot); ATT_DMA_K(t, slot); } while (0)
#define ATT_DMA_V2(t, slot) do { ATT_DMA_V(t, slot); ATT_DMA_V(t, slot); } while (0)
#else
#define ATT_DMA_K2(t, slot) ATT_DMA_K(t, slot)
#define ATT_DMA_V2(t, slot) ATT_DMA_V(t, slot)
#endif
    const int t_lo = d.t_lo, t_hi = d.t_hi;
#if ATT_PIPE
    ATT_DMA_K(t_lo, 0); ATT_DMA_V(t_lo, 0); ATT_DMA_K(t_lo + 1, SLOTB);
#else
    ATT_DMA(t_lo, 0);
    if (t_lo + 1 <= t_hi) ATT_DMA(t_lo + 1, SLOTB);
#endif
    const bf16_t* Qw = ((MODE == 3 && stream == 1) ? d.Q2 : d.Q) + (long)(qblk * 32 + r32) * d.qp + hi * 8;
    bf16x8 qr[4];
#pragma unroll
    for (int d0 = 0; d0 < 4; ++d0) qr[d0] = *reinterpret_cast<const bf16x8*>(Qw + d0 * 16);
    if (HASBIAS) {
        if (MODE == 3) { for (int i = tid; i < 4096; i += 512) { const int rel = i - 2048; tab[i] = (relb[t5_bucket(rel) * 6 + d.head] - (ATT_PIPE ? relb[15 * 6 + d.head] : 0.f)) * LOG2E; } }
        else { for (int i = tid; i < 1024; i += 512) { const int rel = i - 512; const int ar = rel < 0 ? -rel : rel; tab[i] = (ar <= 128) ? relb[t5_bucket(rel) * 6 + d.head] * LOG2E : -1e30f; } }
    }
    const int q0w = d.q0 + qblk * 32;
#if ATT_PIPE
    constexpr int NK = (MODE == 3) ? 2 : 1;
    float mhat = 0.f; f32x16 o[ND0]; f32x16 ol = f32x16{};
#pragma unroll
    for (int i = 0; i < ND0; ++i) o[i] = f32x16{};
    bf16x8 ones;
#pragma unroll
    for (int i = 0; i < 8; ++i) ones[i] = (short)0x3F80;
    asm volatile("" : "+v"(ones));
    float bneg2 = 0.f, bpos2 = 0.f;
    if (MODE == 3) { bneg2 = relb[15 * 6 + d.head] * LOG2E; bpos2 = relb[31 * 6 + d.head] * LOG2E; }
    float cfar = bneg2; bool is_right = false;
    f32x16 negm;
#pragma unroll
    for (int r = 0; r < 16; ++r) negm[r] = cfar;
    asm volatile("" : "+v"(negm));
    bool resc = false;
    const lds_cptr kp0 = l3 + stream * 8192 + hi * 1024 + r32 * 16;
    const lds_cptr vp0 = l3 + VOFF + ((lane >> 4) & 1) * 32 + (lane & 3) * 8 + (4 * hi + ((lane & 15) >> 2)) * 64;
    const ATT_LAS float* tb0 = tab + (-q0w - r32 + 4 * hi + TOFF);
    f32x16 pA0, pA1, pB0, pB1;
    int sl_prev = 0, sl_cur = 0, sl_next = SLOTB;
#define ATT_ROT() do { sl_prev = sl_cur; sl_cur = sl_next; sl_next = (sl_next == 2 * SLOTB) ? 0 : sl_next + SLOTB; } while (0)
#define ATT_RESC() do { if (resc) { asm volatile("s_waitcnt lgkmcnt(0)" ::: "memory"); _Pragma("unroll") for (int r = 0; r < 16; ++r) { const float fr_ = wsf[crow(r, hi)]; ol[r] *= fr_; _Pragma("unroll") for (int i_ = 0; i_ < ND0; ++i_) o[i_][r] *= fr_; } } } while (0)
#define ATT_NEAR(t) (MODE == 0 || (MODE == 3 && (64 * (t) - q0w) >= -153 && (64 * (t) - q0w) <= 121))
#define ATT_CFAR(t) do { if (MODE == 3) { const bool right_ = (64 * (t) - q0w >= 122); if (right_ != is_right) { asm volatile("; far-bias side flips" ::: "memory"); is_right = right_; cfar = right_ ? bpos2 : bneg2; \
        _Pragma("unroll") for (int r = 0; r < 16; ++r) negm[r] = cfar - mhat; asm volatile("" : "+v"(negm)); } } } while (0)
    if (MODE == 3) ATT_WAIT_BAR(4); else ATT_WAIT_BAR(2);
    if (t_lo + 2 <= t_hi) ATT_DMA_K(t_lo + 2, 2 * SLOTB);
    ATT_DMA_V(t_lo + 1, SLOTB);
    ATT_CFAR(t_lo);
    att_qk_plain(pA0, pA1, negm, qr, kp0);
    if (HASBIAS) { if (ATT_NEAR(t_lo)) att_bias(pA0, pA1, tb0 + 64 * t_lo); }
    { const float rm = rowmax(pA0, pA1); float dl = rm; if (MODE == 0) dl = __builtin_fmaxf(rm, d.sink2);
      mhat = dl;
#pragma unroll
      for (int r = 0; r < 16; ++r) { pA0[r] = __builtin_amdgcn_exp2f(pA0[r] - dl); pA1[r] = __builtin_amdgcn_exp2f(pA1[r] - dl); negm[r] = cfar - mhat; }
      asm volatile("" : "+v"(negm));
      if (MODE == 0) { if (hi == 0) wsf[r32] = __builtin_amdgcn_exp2f(d.sink2 - mhat);
          asm volatile("s_waitcnt lgkmcnt(0)" ::: "memory");
#pragma unroll
          for (int r = 0; r < 16; ++r) ol[r] = wsf[crow(r, hi)];
          asm volatile("s_waitcnt lgkmcnt(0)" ::: "memory"); } }
    ATT_ROT();
    int t = t_lo + 1;
#if defined(EXP_DMA2)
#define ATT_STEP_WAIT(t) do { ATT_WAIT_BAR(0); \
        if ((t) + 2 <= t_hi) ATT_DMA_K2((t) + 2, sl_prev); if ((t) + 1 <= t_hi) ATT_DMA_V2((t) + 1, sl_next); } while (0)
#elif defined(EXP_WAIT0)
#define ATT_STEP_WAIT(t) do { ATT_WAIT_BAR(0); \
        if ((t) + 2 <= t_hi) ATT_DMA_K2((t) + 2, sl_prev); if ((t) + 1 <= t_hi) ATT_DMA_V2((t) + 1, sl_next); } while (0)
#elif defined(EXP_BAR2)
#define ATT_STEP_WAIT(t) do { if ((t) < t_hi) { if (MODE == 3) ATT_WAIT_BAR(4); else ATT_WAIT_BAR(2); } else { if (MODE == 3) ATT_WAIT_BAR(2); else ATT_WAIT_BAR(1); } asm volatile("s_barrier" ::: "memory"); \
        if ((t) + 2 <= t_hi) ATT_DMA_K2((t) + 2, sl_prev); if ((t) + 1 <= t_hi) ATT_DMA_V2((t) + 1, sl_next); } while (0)
#else
#define ATT_STEP_WAIT(t) do { if ((t) < t_hi) { if (MODE == 3) ATT_WAIT_BAR(4); else ATT_WAIT_BAR(2); } else { if (MODE == 3) ATT_WAIT_BAR(2); else ATT_WAIT_BAR(1); } \
        if ((t) + 2 <= t_hi) ATT_DMA_K2((t) + 2, sl_prev); if ((t) + 1 <= t_hi) ATT_DMA_V2((t) + 1, sl_next); } while (0)
#endif
    for (; t + 1 <= t_hi; t += 2) {
        ATT_STEP_WAIT(t); ATT_CFAR(t);
        att_step<ND0>(pB0, pB1, pA0, pA1, o, ol, ones, negm, qr, mhat, cfar, resc, wsf, kp0 + sl_cur, vp0 + sl_prev, HASBIAS && ATT_NEAR(t), tb0 + 64 * t, r32, hi);
        ATT_RESC(); ATT_ROT();
        ATT_STEP_WAIT(t + 1); ATT_CFAR(t + 1);
        att_step<ND0>(pA0, pA1, pB0, pB1, o, ol, ones, negm, qr, mhat, cfar, resc, wsf, kp0 + sl_cur, vp0 + sl_prev, HASBIAS && ATT_NEAR(t + 1), tb0 + 64 * (t + 1), r32, hi);
        ATT_RESC(); ATT_ROT();
    }
    if (t <= t_hi) {
        ATT_STEP_WAIT(t); ATT_CFAR(t);
        att_step<ND0>(pB0, pB1, pA0, pA1, o, ol, ones, negm, qr, mhat, cfar, resc, wsf, kp0 + sl_cur, vp0 + sl_prev, HASBIAS && ATT_NEAR(t), tb0 + 64 * t, r32, hi);
        ATT_RESC(); ATT_ROT();
        pA0 = pB0; pA1 = pB1;
    }
    ATT_WAIT_BAR(0);
    att_drain<ND0>(pA0, pA1, o, ol, ones, vp0 + sl_prev);
#undef ATT_STEP_WAIT
#undef ATT_ROT
#undef ATT_RESC
#undef ATT_NEAR
#undef ATT_CFAR
#else
    int tw_lo = t_lo, tw_hi = t_hi;
    if (MODE == 0) { const int a = (q0w + 1024 - 128) / 64 - 16, b = (q0w + 159) / 64; tw_lo = a > t_lo ? a : t_lo; tw_hi = b < t_hi ? b : t_hi; }
    float mhat = 0.f, l_reg = 0.f; f32x16 o[ND0];
#pragma unroll
    for (int i = 0; i < ND0; ++i) o[i] = f32x16{};
    f32x16 negm = f32x16{};
    bool first = true;
    const lds_cptr kp0 = l3 + stream * 8192 + hi * 1024 + r32 * 16;
    const lds_cptr vp0 = l3 + VOFF + ((lane >> 4) & 1) * 32 + (lane & 3) * 8 + (4 * hi + ((lane & 15) >> 2)) * 64;
    int slot = 0;
    for (int t = t_lo; t <= t_hi; ++t) {
        if (t + 1 <= t_hi) { if (MODE == 3) ATT_WAIT_BAR(4); else ATT_WAIT_BAR(2); } else ATT_WAIT_BAR(0);
        if (t + 2 <= t_hi) { const int s2 = (slot >= SLOTB) ? slot - SLOTB : slot + 2 * SLOTB; ATT_DMA(t + 2, s2); }
        if (t >= tw_lo && t <= tw_hi) {
            f32x16 p0, p1;
            { const lds_cptr kb = kp0 + slot;
#pragma unroll
              for (int d0 = 0; d0 < 4; ++d0) {
                  const bf16x8 b0 = *(const ATT_LAS bf16x8*)(kb + d0 * 2048), b1 = *(const ATT_LAS bf16x8*)(kb + d0 * 2048 + 512);
                  if (d0 == 0) { p0 = ATT_MFMA(b0, qr[0], negm); p1 = ATT_MFMA(b1, qr[0], negm); }
                  else { p0 = ATT_MFMA(b0, qr[d0], p0); p1 = ATT_MFMA(b1, qr[d0], p1); } } }
            if (HASBIAS) { const ATT_LAS float* tb = tab + (64 * t - q0w - r32 + 4 * hi + TOFF);
#pragma unroll
                for (int r = 0; r < 16; ++r) { p0[r] += tb[(r & 3) + 8 * (r >> 2)]; p1[r] += tb[32 + (r & 3) + 8 * (r >> 2)]; } }
            const float rm = rowmax(p0, p1);
            if (first) {
                float dl = rm; if (MODE == 0) dl = __builtin_fmaxf(rm, d.sink2);
                mhat = dl;
#pragma unroll
                for (int r = 0; r < 16; ++r) { p0[r] -= dl; p1[r] -= dl; negm[r] = -mhat; }
                if (MODE == 0) l_reg = (hi == 0) ? __builtin_amdgcn_exp2f(d.sink2 - mhat) : 0.f;
                first = false;
            } else if (__any(rm > THR)) {
                const float dl = __builtin_fmaxf(rm, 0.f); mhat += dl;
#pragma unroll
                for (int r = 0; r < 16; ++r) { p0[r] -= dl; p1[r] -= dl; negm[r] = -mhat; }
                const float f = __builtin_amdgcn_exp2f(-dl); l_reg *= f;
                if (hi == 0) wsf[r32] = f;
                asm volatile("s_waitcnt lgkmcnt(0)" ::: "memory");
#pragma unroll
                for (int r = 0; r < 16; ++r) { const float fr = wsf[crow(r, hi)];
#pragma unroll
                    for (int i = 0; i < ND0; ++i) o[i][r] *= fr; }
            }
            float sacc = 0.f;
#pragma unroll
            for (int r = 0; r < 16; ++r) { p0[r] = __builtin_amdgcn_exp2f(p0[r]); p1[r] = __builtin_amdgcn_exp2f(p1[r]); sacc += p0[r] + p1[r]; }
            l_reg += sacc;
            const u32x4 pw0 = {cvtpk(p0[0], p0[1]), cvtpk(p0[2], p0[3]), cvtpk(p0[4], p0[5]), cvtpk(p0[6], p0[7])};
            const u32x4 pw1 = {cvtpk(p0[8], p0[9]), cvtpk(p0[10], p0[11]), cvtpk(p0[12], p0[13]), cvtpk(p0[14], p0[15])};
            const u32x4 pw2 = {cvtpk(p1[0], p1[1]), cvtpk(p1[2], p1[3]), cvtpk(p1[4], p1[5]), cvtpk(p1[6], p1[7])};
            const u32x4 pw3 = {cvtpk(p1[8], p1[9]), cvtpk(p1[10], p1[11]), cvtpk(p1[12], p1[13]), cvtpk(p1[14], p1[15])};
            const lds_cptr vb = vp0 + slot;
#pragma unroll
            for (int d0 = 0; d0 < ND0; ++d0) {
                if (ND0 > 2) asm volatile("" ::: "memory");
#define ATT_VF(ks) ({ const s16x4 lo_ = vtr(vb + d0 * 4096 + (ks) * 1024), hi_ = vtr(vb + d0 * 4096 + (ks) * 1024 + 512); (bf16x8){lo_[0], lo_[1], lo_[2], lo_[3], hi_[0], hi_[1], hi_[2], hi_[3]}; })
                o[d0] = ATT_MFMA(__builtin_bit_cast(bf16x8, pw0), ATT_VF(0), o[d0]);
                o[d0] = ATT_MFMA(__builtin_bit_cast(bf16x8, pw1), ATT_VF(1), o[d0]);
                o[d0] = ATT_MFMA(__builtin_bit_cast(bf16x8, pw2), ATT_VF(2), o[d0]);
                o[d0] = ATT_MFMA(__builtin_bit_cast(bf16x8, pw3), ATT_VF(3), o[d0]);
#undef ATT_VF
            }
        }
        slot = (slot == 2 * SLOTB) ? 0 : slot + SLOTB;
    }
#endif
    int lane_e = lane; asm volatile("" : "+v"(lane_e));
#if !ATT_PIPE
    l_reg = halfsum(l_reg);
#endif
    if (MODE != 3) {
#if !ATT_PIPE
        if (hi == 0) wsf[32 + r32] = l_reg;
        asm volatile("s_waitcnt lgkmcnt(0)" ::: "memory");
#endif
        ATT_LAS bf16_t* stg = (ATT_LAS bf16_t*)(l3 + LDS_OST) + wid * 2048;
#pragma unroll
        for (int r = 0; r < 16; ++r) { const int orow = crow(r, hi);
#if ATT_PIPE
            const float rl = __builtin_amdgcn_rcpf(ol[r]);
#else
            const float rl = __builtin_amdgcn_rcpf(wsf[32 + orow]);
#endif
#pragma unroll
            for (int d0 = 0; d0 < 2; ++d0) { const unsigned w = cvtpk(o[d0][r] * rl, 0.f); stg[orow * 64 + d0 * 32 + r32] = (bf16_t)(w & 0xffffu); } }
        asm volatile("s_waitcnt lgkmcnt(0)" ::: "memory");
        bf16_t* Ow = d.O + (long)(qblk * 32) * d.op; const bf16_t* Gw = d.G + (long)(qblk * 32) * d.gp;
#pragma unroll
        for (int i = 0; i < 4; ++i) { const int row = i * 8 + (lane_e >> 3), ch = lane_e & 7;
            const u32x4 v = *(const ATT_LAS u32x4*)(stg + row * 64 + ch * 8); const u32x4 g = *(const u32x4*)(Gw + (long)row * d.gp + ch * 8);
            u32x4 w; w.x = cvtpk(bflo(v.x) * bflo(g.x), bfhi(v.x) * bfhi(g.x)); w.y = cvtpk(bflo(v.y) * bflo(g.y), bfhi(v.y) * bfhi(g.y));
            w.z = cvtpk(bflo(v.z) * bflo(g.z), bfhi(v.z) * bfhi(g.z)); w.w = cvtpk(bflo(v.w) * bflo(g.w), bfhi(v.w) * bfhi(g.w));
            *(u32x4*)(Ow + (long)row * d.op + ch * 8) = w; }
        asm volatile("s_waitcnt lgkmcnt(0)\n\ts_barrier" ::: "memory");
    } else {
        asm volatile("s_waitcnt vmcnt(0) lgkmcnt(0)\n\ts_barrier" ::: "memory");
        ATT_LAS float* X = (ATT_LAS float*)l3 + qblk * 4096;
#if !ATT_PIPE
        if (hi == 0) wsf[32 + r32] = (stream == 0) ? __builtin_amdgcn_rcpf(l_reg) : lam * __builtin_amdgcn_rcpf(l_reg);
        asm volatile("s_waitcnt lgkmcnt(0)" ::: "memory");
#endif
#pragma unroll
        for (int r = 0; r < 16; ++r) {
#if ATT_PIPE
            const float fr = (stream == 0) ? __builtin_amdgcn_rcpf(ol[r]) : lam * __builtin_amdgcn_rcpf(ol[r]);
#else
            const float fr = wsf[32 + crow(r, hi)];
#endif
#pragma unroll
            for (int i = 0; i < ND0; ++i) o[i][r] *= fr; }
        if (stream == 1) {
#pragma unroll
            for (int i = 0; i < ND0; ++i)
#pragma unroll
                for (int r = 0; r < 16; ++r) X[(i * 16 + r) * 64 + lane] = o[i][r];
        }
        asm volatile("s_waitcnt lgkmcnt(0)\n\ts_barrier" ::: "memory");
        if (stream == 0) {
            float ss[16];
#pragma unroll
            for (int r = 0; r < 16; ++r) ss[r] = 0.f;
#pragma unroll
            for (int i = 0; i < ND0; ++i)
#pragma unroll
                for (int r = 0; r < 16; ++r) { o[i][r] -= X[(i * 16 + r) * 64 + lane]; ss[r] += o[i][r] * o[i][r]; }
            asm volatile("s_waitcnt lgkmcnt(0)" ::: "memory");
#pragma unroll
            for (int r = 0; r < 16; ++r) {
#pragma unroll
                for (int off = 1; off < 32; off <<= 1) ss[r] += __shfl_xor(ss[r], off);
                ss[r] = __builtin_amdgcn_rsqf(ss[r] * (1.0f / 128.0f) + 1e-6f) * sub_scale; }
            ATT_LAS bf16_t* stg = (ATT_LAS bf16_t*)X;
#pragma unroll
            for (int i = 0; i < ND0; ++i) { const float gsub = subg[i * 32 + r32];
#pragma unroll
                for (int r = 0; r < 16; ++r) { const unsigned w = cvtpk(o[i][r] * ss[r] * gsub, 0.f); stg[crow(r, hi) * 128 + i * 32 + r32] = (bf16_t)(w & 0xffffu); } }
            asm volatile("s_waitcnt lgkmcnt(0)" ::: "memory");
            bf16_t* Ow = d.O + (long)(qblk * 32) * d.op; const bf16_t* Gw = d.G + (long)(qblk * 32) * d.gp;
#pragma unroll
            for (int i = 0; i < 8; ++i) { const int piece = i * 64 + lane_e, row = piece >> 4, ch = piece & 15;
                const u32x4 v = *(const ATT_LAS u32x4*)(stg + row * 128 + ch * 8); const u32x4 g = *(const u32x4*)(Gw + (long)row * d.gp + ch * 8);
                u32x4 w; w.x = cvtpk(bflo(v.x) * bflo(g.x), bfhi(v.x) * bfhi(g.x)); w.y = cvtpk(bflo(v.y) * bflo(g.y), bfhi(v.y) * bfhi(g.y));
                w.z = cvtpk(bflo(v.z) * bflo(g.z), bfhi(v.z) * bfhi(g.z)); w.w = cvtpk(bflo(v.w) * bflo(g.w), bfhi(v.w) * bfhi(g.w));
                *(u32x4*)(Ow + (long)row * d.op + ch * 8) = w; }
        }
        asm volatile("s_waitcnt lgkmcnt(0)\n\ts_barrier" ::: "memory");
    }
#undef ATT_DMA
#undef ATT_DMA_K
#undef ATT_DMA_V
}
}

constexpr int NWAVES = 8;
#ifndef MK_ONE_LAUNCH
#define MK_ONE_LAUNCH 1
#endif
constexpr int NPHASE = 10;

constexpr int BATCH = 8, SEQ = 2048, D = 1024, MEM = 256;
constexpr int M = BATCH * SEQ;
constexpr int MM = BATCH * MEM;
constexpr int N0 = 2560, N1 = 3584;
constexpr float EPS = 1e-6f;
constexpr float LAM_INIT = 0.35550906759096934f;
constexpr int L0_AQ = 0, L0_AK = 384, L0_AV = 512, L0_BQ = 640, L0_BK = 1024, L0_BV = 1152, L0_XQ = 1280, L0_G = 1536;
constexpr int L1_Q1 = 0, L1_Q2 = 384, L1_K1 = 768, L1_K2 = 1152, L1_V = 1536, L1_XQ = 2304, L1_G = 2560;

constexpr size_t MiB = 1u << 20;
constexpr size_t WS_CTL = 0, CTL_ZERO_BYTES = 1 * MiB;
constexpr size_t WS_W0 = 2 * MiB;
constexpr size_t WS_WM = WS_W0 + (size_t)N0 * D * 2;
constexpr size_t WS_WO0 = WS_WM + (size_t)1024 * D * 2;
constexpr size_t WS_W1 = WS_WO0 + (size_t)D * D * 2;
constexpr size_t WS_WO1 = WS_W1 + (size_t)N1 * D * 2;
constexpr size_t WS_XN = 24 * MiB;
constexpr size_t WS_MN = WS_XN + (size_t)M * D * 2;
constexpr size_t WS_MKV = WS_MN + (size_t)MM * D * 2;
constexpr size_t WS_Y = WS_MKV + (size_t)MM * 1024 * 2;
constexpr size_t WS_PR = WS_Y + (size_t)M * D * 2;
constexpr size_t WS_END = WS_PR + (size_t)M * N1 * 2;
static_assert(WS_WO1 + (size_t)D * D * 2 <= WS_XN && WS_END <= 256 * MiB, "d_ws map");
constexpr int CW_BAR = 4096;

constexpr int RING_OFF = 0, RING_BYTES = 131072;
constexpr int LDSCTL_OFF = RING_BYTES, MISC_OFF = LDSCTL_OFF + 320;
constexpr int LDS_BYTES = 147456;
static_assert(MISC_OFF + 128 <= LDS_BYTES && att::LDS_END <= RING_BYTES, "LDS map");

#define GAS __attribute__((address_space(1)))
#define LAS __attribute__((address_space(3)))
typedef unsigned short bf16;
typedef unsigned v4u __attribute__((ext_vector_type(4)));
typedef float f32x4 __attribute__((ext_vector_type(4)));
typedef GAS unsigned gu32;
#define RLX_AGENT __ATOMIC_RELAXED, __HIP_MEMORY_SCOPE_AGENT
#define LDS_WAIT() asm volatile("s_waitcnt lgkmcnt(0)" ::: "memory")
#define VM_WAIT() asm volatile("s_waitcnt vmcnt(0)" ::: "memory")
__device__ __forceinline__ unsigned pk2(float lo, float hi) { return pg8::cvt_pk_bf16(lo, hi); }

#define XB_TMO      128
#define XB_XCNT(j)  (256  + 64 * (j))
#define XB_XSUB(j)  (1280 + 64 * (j))
#define XB_XGEN(j)  (2304 + 64 * (j))
#define XB_TOP      3328
#define XB_TOPGEN   3392
#define XCD_BAR_WORDS 3456
#define XB_SPIN_CAP (1u << 18)

__device__ __forceinline__ unsigned xb_ld(unsigned* p)              { return __hip_atomic_load(p, __ATOMIC_RELAXED, __HIP_MEMORY_SCOPE_AGENT); }
__device__ __forceinline__ unsigned xb_add(unsigned* p, unsigned v) { return __hip_atomic_fetch_add(p, v, __ATOMIC_RELAXED, __HIP_MEMORY_SCOPE_AGENT); }
__device__ __forceinline__ unsigned xb_xcc_id() { return (unsigned)__builtin_amdgcn_s_getreg((3 << 11) | 20) & 0xFu; }
#define XB_SPIN(cond, bar) do { unsigned _sp = 0; while (cond) { __builtin_amdgcn_s_sleep(1); \
    if ((++_sp & 255u) == 0u) { if (xb_ld(&(bar)[XB_TMO])) break; if (_sp > XB_SPIN_CAP) { atomicAdd(&(bar)[XB_TMO], 1u); break; } } } } while (0)

struct XcdBarrier {
    unsigned* bar; unsigned x;
    volatile LAS unsigned* st;
};

__device__ __forceinline__ XcdBarrier xcd_barrier_post(unsigned* bar, volatile LAS unsigned* st) {
    XcdBarrier b; b.bar = bar; b.x = xb_xcc_id(); b.st = st;
    if (threadIdx.x == 0) (void)xb_add(&bar[XB_XCNT(b.x)], 1u);
    return b;
}
__device__ __forceinline__ void xcd_barrier_complete(unsigned* bar, unsigned x, unsigned& nloc, unsigned& nx) {
    const unsigned G = gridDim.x * gridDim.y * gridDim.z;
    unsigned sum, cnt, mine, sp = 0u;
    for (;;) {
        sum = 0u; cnt = 0u; mine = 0u;
#pragma unroll
        for (unsigned j = 0; j < 16; ++j) { const unsigned c = xb_ld(&bar[XB_XCNT(j)]); sum += c; cnt += (c > 0u) ? 1u : 0u; mine = (j == x) ? c : mine; }
        if (sum == G) break;
        __builtin_amdgcn_s_sleep(1);
        if ((++sp & 255u) == 0u) { if (xb_ld(&bar[XB_TMO])) break; if (sp > XB_SPIN_CAP) { atomicAdd(&bar[XB_TMO], 1u); break; } }
    }
    nloc = mine > 0u ? mine : 1u; nx = cnt > 0u ? cnt : 1u;
}

__device__ __forceinline__ void xcd_barrier(const XcdBarrier& b) {
    asm volatile("s_waitcnt vmcnt(0)" ::: "memory");
    __syncthreads();
    if (threadIdx.x == 0) {
        unsigned* bar = b.bar;
        __builtin_amdgcn_s_waitcnt(0);
        unsigned nloc = b.st[0], nx = b.st[1];
        if (nloc == 0u) { xcd_barrier_complete(bar, b.x, nloc, nx); b.st[0] = nloc; b.st[1] = nx; }
        const unsigned old = xb_add(&bar[XB_XSUB(b.x)], 1u);
        const unsigned gen = old / nloc;
        if (old + 1u == (gen + 1u) * nloc) {
            __builtin_amdgcn_fence(__ATOMIC_RELEASE, "agent");
            asm volatile("s_waitcnt vmcnt(0)" ::: "memory");
            const unsigned og = xb_add(&bar[XB_TOP], 1u);
            const unsigned tg = og / nx;
            if (og + 1u == (tg + 1u) * nx) xb_add(&bar[XB_TOPGEN], 1u);
            else XB_SPIN(xb_ld(&bar[XB_TOPGEN]) == tg, bar);
            __builtin_amdgcn_fence(__ATOMIC_ACQUIRE, "agent");
            xb_add(&bar[XB_XGEN(b.x)], 1u);
            asm volatile("s_waitcnt vmcnt(0)" ::: "memory");
        } else {
            XB_SPIN(xb_ld(&bar[XB_XGEN(b.x)]) == gen, bar);
            __builtin_amdgcn_fence(__ATOMIC_ACQUIRE, "agent");
            asm volatile("s_waitcnt vmcnt(0)" ::: "memory");
        }
    }
    __syncthreads();
}


struct Frame {
    LAS unsigned char* lds;
    volatile LAS unsigned* MISC;
    gu32* ctl;
    int tid, lane, wave;
    int vcu, G;
};

__device__ __forceinline__ float wave_sum(float v) {
#pragma unroll
    for (int o = 1; o < 64; o <<= 1) v += __shfl_xor(v, o);
    return v;
}
__device__ __forceinline__ void p0_transpose_item(const float* W, int K, int N, bf16* WT, int row_off, LAS float* scr, int item, int lane) {
    const int nblk = N / 32, kb = item / nblk, nb = item % nblk, k0 = 64 * kb, n0 = 32 * nb;
#pragma unroll 8
    for (int i = 0; i < 32; ++i) { const int kk = 2 * i + (lane >> 5); scr[kk * 33 + (lane & 31)] = W[(size_t)(k0 + kk) * N + n0 + (lane & 31)]; }
    LDS_WAIT(); asm volatile("" ::: "memory");
    const int c = lane & 7;
#pragma unroll
    for (int j = 0; j < 4; ++j) { const int n = (lane >> 3) + 8 * j; const LAS float* s = scr + (8 * c) * 33 + n;
        v4u o; o.x = pk2(s[0 * 33], s[1 * 33]); o.y = pk2(s[2 * 33], s[3 * 33]); o.z = pk2(s[4 * 33], s[5 * 33]); o.w = pk2(s[6 * 33], s[7 * 33]);
        *(GAS v4u*)(WT + (size_t)(row_off + n0 + n) * K + k0 + 8 * c) = o; }
    LDS_WAIT(); asm volatile("" ::: "memory");
}
__device__ __forceinline__ void rms_row_to_bf16(int lane, const float* xrow, const float* g, bf16* orow) {
    const GAS f32x4* xr = (const GAS f32x4*)xrow + lane; const GAS f32x4* gr = (const GAS f32x4*)g + lane;
    f32x4 v[4]; float s = 0.f;
#pragma unroll
    for (int j = 0; j < 4; ++j) { v[j] = xr[64 * j]; s += (v[j].x * v[j].x + v[j].y * v[j].y) + (v[j].z * v[j].z + v[j].w * v[j].w); }
    const float rstd = __builtin_amdgcn_rsqf(wave_sum(s) * (1.f / D) + EPS);
    GAS unsigned long long* o8 = (GAS unsigned long long*)orow + lane;
#pragma unroll
    for (int j = 0; j < 4; ++j) { const f32x4 gg = gr[64 * j];
        o8[64 * j] = (unsigned long long)pk2(v[j].x * rstd * gg.x, v[j].y * rstd * gg.y) | ((unsigned long long)pk2(v[j].z * rstd * gg.z, v[j].w * rstd * gg.w) << 32); }
}
__device__ __forceinline__ void rms_row_inplace(int lane, float* xrow, const float* g) {
    GAS f32x4* xr = (GAS f32x4*)xrow + lane; const GAS f32x4* gr = (const GAS f32x4*)g + lane;
    f32x4 v[4]; float s = 0.f;
#pragma unroll
    for (int j = 0; j < 4; ++j) { v[j] = xr[64 * j]; s += (v[j].x * v[j].x + v[j].y * v[j].y) + (v[j].z * v[j].z + v[j].w * v[j].w); }
    const float rstd = __builtin_amdgcn_rsqf(wave_sum(s) * (1.f / D) + EPS);
#pragma unroll
    for (int j = 0; j < 4; ++j) { const f32x4 gg = gr[64 * j]; xr[64 * j] = v[j] * rstd * gg; }
}

struct Args { const float* in[21]; float* out; unsigned char* ws; int ph_lo, ph_hi; };

__device__ __forceinline__ void normrope_row(int lane, bf16* prow, int pos, const float* qn, const float* kn) {
    const int hh = lane >> 3, j = lane & 7;
    bf16* p = prow + (hh < 6 ? L0_BQ + hh * 64 : L0_BK + (hh - 6) * 64) + 8 * j;
    const v4u raw = *(const GAS v4u*)p;
    float x[8]; x[0] = att::bflo(raw.x); x[1] = att::bfhi(raw.x); x[2] = att::bflo(raw.y); x[3] = att::bfhi(raw.y); x[4] = att::bflo(raw.z); x[5] = att::bfhi(raw.z); x[6] = att::bflo(raw.w); x[7] = att::bfhi(raw.w);
    float ss = 0.f;
#pragma unroll
    for (int e = 0; e < 8; ++e) ss += x[e] * x[e];
    ss += __shfl_xor(ss, 1); ss += __shfl_xor(ss, 2); ss += __shfl_xor(ss, 4);
    const float rstd = __builtin_amdgcn_rsqf(ss * (1.f / 64.f) + EPS);
    const float* gn = (hh < 6 ? qn : kn) + 8 * j;
    const float posax = (float)((j < 4) ? (pos >> 6) : (pos & 63));
    const bool is_x2 = (j & 2) != 0;
    float y[8];
#pragma unroll
    for (int e = 0; e < 8; ++e) y[e] = x[e] * rstd * gn[e];
    float outv[8];
#pragma unroll
    for (int e = 0; e < 8; ++e) {
        const float other = __shfl_xor(y[e], 2);
        const int fi = 8 * (j & 1) + e;
        const float inv = __builtin_amdgcn_exp2f(-(float)fi * (13.287712379549449f / 16.0f));
        const float ang = posax * inv; const float c = __cosf(ang), s = __sinf(ang);
        outv[e] = is_x2 ? (other * s + y[e] * c) : (y[e] * c - other * s);
    }
    const float sc = (hh < 6) ? att::C2 : 1.0f;
    v4u w; w.x = pk2(outv[0] * sc, outv[1] * sc); w.y = pk2(outv[2] * sc, outv[3] * sc); w.z = pk2(outv[4] * sc, outv[5] * sc); w.w = pk2(outv[6] * sc, outv[7] * sc);
    *(GAS v4u*)p = w;
}

__global__ void __launch_bounds__(NWAVES * 64, 2) mk_fwd(Args args) {
    extern __shared__ __attribute__((aligned(16))) unsigned char lds[];
    Frame F;
    F.lds = (LAS unsigned char*)lds;
    F.MISC = (volatile LAS unsigned*)(F.lds + MISC_OFF);
    F.tid = threadIdx.x; F.lane = F.tid & 63; F.wave = __builtin_amdgcn_readfirstlane(F.tid >> 6);
    F.G = gridDim.x; { const int bx = blockIdx.x; F.vcu = (F.G % 8 == 0) ? (bx % 8) * (F.G / 8) + bx / 8 : bx; }
    unsigned char* ws = args.ws;
    F.ctl = (gu32*)(ws + WS_CTL);
    const float* x = args.in[0]; const float* mem = args.in[1]; const float* relb = args.in[2]; const float* mem_norm = args.in[3]; const float* final_norm = args.in[4];
    const float* even_norm = args.in[5]; const float* even_w_in = args.in[6]; const float* even_sink = args.in[7]; const float* even_qn = args.in[8]; const float* even_kn = args.in[9];
    const float* even_wmkv = args.in[10]; const float* even_wout = args.in[11]; const float* odd_norm = args.in[12]; const float* odd_w_in = args.in[13];
    const float* lq1 = args.in[14]; const float* lk1 = args.in[15]; const float* lq2 = args.in[16]; const float* lk2 = args.in[17]; const float* odd_subln = args.in[18];
    const float* odd_wmkv = args.in[19]; const float* odd_wout = args.in[20];
    float* out = args.out;
    bf16* W0t = (bf16*)(ws + WS_W0); bf16* Wmt = (bf16*)(ws + WS_WM); bf16* Wo0t = (bf16*)(ws + WS_WO0); bf16* W1t = (bf16*)(ws + WS_W1); bf16* Wo1t = (bf16*)(ws + WS_WO1);
    bf16* XN = (bf16*)(ws + WS_XN); bf16* MN = (bf16*)(ws + WS_MN); bf16* MKV = (bf16*)(ws + WS_MKV); bf16* Y = (bf16*)(ws + WS_Y); bf16* PR = (bf16*)(ws + WS_PR);

    for (int u = F.tid; u < (LDS_BYTES - LDSCTL_OFF) / 4; u += NWAVES * 64) ((LAS unsigned*)(F.lds + LDSCTL_OFF))[u] = 0u;
    __syncthreads();
    XcdBarrier bar; bar.bar = (unsigned*)(F.ctl + CW_BAR); bar.x = 0; bar.st = nullptr;
    const int lo = args.ph_lo, hi = args.ph_hi;
    if (hi - lo > 1) bar = xcd_barrier_post((unsigned*)(F.ctl + CW_BAR), F.MISC + 8);
#ifndef PH_MASK
#define PH_MASK 0x3ff
#endif
#define IN(k) (((PH_MASK >> (k)) & 1) && lo <= (k) && (k) < hi)
#ifndef REP_MASK
#define REP_MASK 0
#endif
#define NREP(k) (1 + ((REP_MASK >> (k)) & 1))
#define SEAM(k) do { if (IN(k) && IN((k) + 1)) xcd_barrier(bar); } while (0)
    const int gw = F.vcu * NWAVES + F.wave, NGW = F.G * NWAVES;

    if (IN(0)) {
        LAS float* scr = (LAS float*)(F.lds + RING_OFF + F.wave * 16384);
        constexpr int I_W0 = 16 * (N0 / 32), I_MK = 16 * (512 / 32), I_WO = 16 * (D / 32), I_W1 = 16 * (N1 / 32);
        constexpr int NITEMS = I_W0 + 2 * I_MK + 2 * I_WO + I_W1;
        for (int it = gw; it < NITEMS; it += NGW) {
            int r = it;
            if (r < I_W0) { p0_transpose_item(even_w_in, D, N0, W0t, 0, scr, r, F.lane); continue; } r -= I_W0;
            if (r < I_MK) { p0_transpose_item(even_wmkv, D, 512, Wmt, 0, scr, r, F.lane); continue; } r -= I_MK;
            if (r < I_MK) { p0_transpose_item(odd_wmkv, D, 512, Wmt, 512, scr, r, F.lane); continue; } r -= I_MK;
            if (r < I_WO) { p0_transpose_item(even_wout, D, D, Wo0t, 0, scr, r, F.lane); continue; } r -= I_WO;
            if (r < I_W1) { p0_transpose_item(odd_w_in, D, N1, W1t, 0, scr, r, F.lane); continue; } r -= I_W1;
            p0_transpose_item(odd_wout, D, D, Wo1t, 0, scr, r, F.lane);
        }
        for (int m = gw; m < M + MM; m += NGW) {
            if (m < M) rms_row_to_bf16(F.lane, x + (size_t)m * D, even_norm, XN + (size_t)m * D);
            else rms_row_to_bf16(F.lane, mem + (size_t)(m - M) * D, mem_norm, MN + (size_t)(m - M) * D);
        }
    }
    SEAM(0);
    for (int rep_ = 0; rep_ < NREP(1); ++rep_) if (IN(1)) {
        pg8::Gemm g{XN, W0t, M + MM, N0 + 1024, D}; pg8::ProjOrder S; S.init(M, N0, F.G, (int)blockIdx.x, 32, M / 256, N0 / 256);
        pg8::EpiProj E{PR, N0, 0x00000C07u, 0x000FF000u, att::C2, MKV, 1024, M / 256, N0 / 256};
        pg8::gemm_phase<pg8::EpiProj, pg8::ProjOrder, true, true>(F.lds + RING_OFF, g, S, E);
    }
    SEAM(1);
    if (IN(2)) {
        for (int m = gw; m < M; m += NGW) normrope_row(F.lane, PR + (size_t)m * N0, m & (SEQ - 1), even_qn, even_kn);
    }
    SEAM(2);
    if (IN(3)) {
        const int nslots = (F.G == 256) ? 6 : (1024 + F.G - 1) / F.G;
        for (int ii = 0; ii < nslots * NREP(3); ++ii) { const int i = ii >= nslots ? ii - nslots : ii;
            int kind = -1, b = 0, u = 0;
            if (F.G == 256) { b = F.vcu >> 5; const int j = F.vcu & 31;
                if (j < 16) { if (i < 2) { kind = 1; u = 2 * j + i; } else if (i == 2) { kind = 2; u = j; } }
                else { const int k = j - 16; if (i == 0) { kind = 1; u = 32 + k; } else if (i < 4) { kind = 0; u = 3 * k + (i - 1); } else if (i == 4) { kind = 2; u = 16 + k; } } }
            else { const int L = i * F.G + (int)blockIdx.x; if (L < 384) { kind = 1; b = L / 48; u = L % 48; } else if (L < 768) { kind = 0; b = (L - 384) / 48; u = (L - 384) % 48; } else if (L < 1024) { kind = 2; b = (L - 768) / 32; u = (L - 768) % 32; } }
            if (kind < 0) continue;
            const int h = u >> 3, qb = u & 7, q0 = qb * 256; const size_t row0 = (size_t)b * SEQ;
            att::UnitD d; d.qp = N0; d.op = D; d.gp = N0; d.q0 = q0; d.Q2 = nullptr; d.K2 = nullptr; d.head = h; d.sink2 = 0.f;
            const bf16* prq = PR + (row0 + q0) * N0; const bf16* prk = PR + row0 * N0;
            if (kind == 0) { const int kvh = h / 3; d.Q = prq + L0_AQ + h * 64; d.K = prk + L0_AK + kvh * 64; d.V = prk + L0_AV + kvh * 64; d.kp = N0;
                d.O = Y + (row0 + q0) * D + h * 64; d.G = prq + L0_G + h * 64; d.sink2 = even_sink[h] * att::LOG2E;
                const int tl = q0 / 64 - 2, th = q0 / 64 + 5; d.t_lo = tl < 0 ? 0 : tl; d.t_hi = th > 31 ? 31 : th;
                att::attn_unit<0>(d, (char*)lds + RING_OFF, relb, nullptr, 0.f, 0.f); }
            else if (kind == 1) { const int kvh = h / 3; d.Q = prq + L0_BQ + h * 64; d.K = prk + L0_BK + kvh * 64; d.V = prk + L0_BV + kvh * 64; d.kp = N0;
                d.O = Y + (row0 + q0) * D + 384 + h * 64; d.G = prq + L0_G + 384 + h * 64; d.t_lo = 0; d.t_hi = 31;
                att::attn_unit<1>(d, (char*)lds + RING_OFF, relb, nullptr, 0.f, 0.f); }
            else { const bf16* mk = MKV + (size_t)b * MEM * 1024; d.Q = prq + L0_XQ + h * 64; d.K = mk + h * 64; d.V = mk + 256 + h * 64; d.kp = 1024;
                d.O = Y + (row0 + q0) * D + 768 + h * 64; d.G = prq + L0_G + 768 + h * 64; d.t_lo = 0; d.t_hi = 3;
                att::attn_unit<2>(d, (char*)lds + RING_OFF, relb, nullptr, 0.f, 0.f); }
        }
    }
    SEAM(3);
    for (int rep_ = 0; rep_ < NREP(4); ++rep_) if (IN(4)) {
        pg8::Gemm g{Y, Wo0t, M, D, D}; pg8::ProjOrder S; S.init(M, D, F.G, (int)blockIdx.x, 0, 0, 0);
        pg8::EpiRes E{x, out, D};
        pg8::gemm_phase<pg8::EpiRes, pg8::ProjOrder, false, true>(F.lds + RING_OFF, g, S, E);
    }
    SEAM(4);
    if (IN(5)) {
        for (int m = gw; m < M; m += NGW) rms_row_to_bf16(F.lane, out + (size_t)m * D, odd_norm, XN + (size_t)m * D);
    }
    SEAM(5);
    for (int rep_ = 0; rep_ < NREP(6); ++rep_) if (IN(6)) {
        pg8::Gemm g{XN, W1t, M, N1, D}; pg8::ProjOrder S; S.init(M, N1, F.G, (int)blockIdx.x, 0, 0, 0);
        pg8::EpiProj E{PR, N1, 0x000C003Fu, 0x0FF00000u, att::C2, nullptr, 0, 1 << 20, 0};
        pg8::gemm_phase<pg8::EpiProj, pg8::ProjOrder, true, true>(F.lds + RING_OFF, g, S, E);
    }
    SEAM(6);
    if (IN(7)) {
        float lam;
        { const float a = lq1[F.lane] * lk1[F.lane], c = lq2[F.lane] * lk2[F.lane]; lam = __expf(wave_sum(a)) - __expf(wave_sum(c)) + LAM_INIT; }
        const int nslots = (F.G == 256) ? 4 : (1024 + F.G - 1) / F.G;
        for (int ii = 0; ii < nslots * NREP(7); ++ii) { const int i = ii >= nslots ? ii - nslots : ii;
            int kind = -1, b = 0, h = 0, qb = 0;
            if (F.G == 256) { b = F.vcu >> 5; const int j = F.vcu & 31; if (i < 3) { kind = 3; h = 2 * i + (j >> 4); qb = j & 15; } else { kind = 2; h = j >> 3; qb = j & 7; } }
            else { const int L = i * F.G + (int)blockIdx.x; if (L < 768) { kind = 3; b = L / 96; h = (L % 96) / 16; qb = L % 16; } else if (L < 1024) { kind = 2; b = (L - 768) / 32; h = ((L - 768) % 32) / 8; qb = L % 8; } }
            if (kind < 0) continue;
            const size_t row0 = (size_t)b * SEQ;
            att::UnitD d; d.qp = N1; d.op = D; d.gp = N1; d.Q2 = nullptr; d.K2 = nullptr; d.head = h; d.sink2 = 0.f;
            if (kind == 3) { const int q0 = qb * 128; const bf16* prq = PR + (row0 + q0) * N1; const bf16* prk = PR + row0 * N1; d.q0 = q0;
                d.Q = prq + L1_Q1 + h * 64; d.Q2 = prq + L1_Q2 + h * 64; d.K = prk + L1_K1 + h * 64; d.K2 = prk + L1_K2 + h * 64; d.V = prk + L1_V + h * 128; d.kp = N1;
                d.O = Y + (row0 + q0) * D + h * 128; d.G = prq + L1_G + h * 128; d.t_lo = 0; d.t_hi = 31;
                att::attn_unit<3>(d, (char*)lds + RING_OFF, relb, odd_subln, lam, 1.0f - LAM_INIT); }
            else { const int q0 = qb * 256; const bf16* prq = PR + (row0 + q0) * N1; d.q0 = q0; const bf16* mk = MKV + (size_t)b * MEM * 1024;
                d.Q = prq + L1_XQ + h * 64; d.K = mk + 512 + h * 64; d.V = mk + 768 + h * 64; d.kp = 1024;
                d.O = Y + (row0 + q0) * D + 768 + h * 64; d.G = prq + L1_G + 768 + h * 64; d.t_lo = 0; d.t_hi = 3;
                att::attn_unit<2>(d, (char*)lds + RING_OFF, relb, nullptr, 0.f, 0.f); }
        }
    }
    SEAM(7);
    if (IN(8)) {
        pg8::Gemm g{Y, Wo1t, M, D, D}; pg8::ProjOrder S; S.init(M, D, F.G, (int)blockIdx.x, 0, 0, 0);
        pg8::EpiRes E{out, out, D};
        pg8::gemm_phase<pg8::EpiRes, pg8::ProjOrder, false, true>(F.lds + RING_OFF, g, S, E);
    }
    SEAM(8);
    if (IN(9)) {
        for (int m = gw; m < M; m += NGW) rms_row_inplace(F.lane, out + (size_t)m * D, final_norm);
    }
#undef IN
#undef SEAM
}

extern "C" void kernel_launch(void* const* d_in, const int* in_sizes, int n_in, void* d_out, int out_size, void* d_ws, size_t ws_size, hipStream_t stream) {
    static int grid = 0;
    if (grid == 0) {
        if (n_in != 21 || in_sizes[0] != M * D || out_size != M * D || ws_size < WS_END) { fprintf(stderr, "kernel_launch: unexpected shapes (n_in %d, in0 %d, out %d, ws %zu); nothing launched\n", n_in, n_in > 0 ? in_sizes[0] : -1, out_size, ws_size); grid = -1; return; }
        int dev = 0, cus = 0, per_cu = 0;
        if (hipGetDevice(&dev) != hipSuccess || hipDeviceGetAttribute(&cus, hipDeviceAttributeMultiprocessorCount, dev) != hipSuccess) { grid = -1; return; }
        if (hipFuncSetAttribute((const void*)mk_fwd, hipFuncAttributeMaxDynamicSharedMemorySize, LDS_BYTES) != hipSuccess) { fprintf(stderr, "kernel_launch: hipFuncSetAttribute failed\n"); grid = -1; return; }
        if (hipOccupancyMaxActiveBlocksPerMultiprocessor(&per_cu, (const void*)mk_fwd, NWAVES * 64, LDS_BYTES) != hipSuccess || per_cu < 1) { fprintf(stderr, "kernel_launch: occupancy query reports %d blocks per CU\n", per_cu); (void)hipGetLastError(); grid = -1; return; }
        grid = cus;
    }
    if (grid < 0) return;
    (void)hipMemsetAsync((char*)d_ws + WS_CTL, 0, CTL_ZERO_BYTES, stream);
    Args a{};
    for (int i = 0; i < 21; ++i) a.in[i] = (const float*)d_in[i];
    a.out = (float*)d_out; a.ws = (unsigned char*)d_ws;
#if MK_ONE_LAUNCH
    a.ph_lo = 0; a.ph_hi = NPHASE;
    void* kargs[] = {&a};
    hipError_t e = hipLaunchCooperativeKernel((const void*)mk_fwd, dim3(grid), dim3(NWAVES * 64), kargs, LDS_BYTES, stream);
    if (e != hipSuccess) fprintf(stderr, "kernel_launch: cooperative launch failed: %s (grid %d)\n", hipGetErrorString(e), grid);
#else
    for (int p = 0; p < NPHASE; ++p) { a.ph_lo = p; a.ph_hi = p + 1; hipLaunchKernelGGL(mk_fwd, dim3(grid), dim3(NWAVES * 64), LDS_BYTES, stream, a); }
#endif
}
```
